# Optimizing an MI355X kernel written in HIP

```python
import jax, jax.numpy as jnp
from jax import lax
import numpy as np

D_MODEL = 1024
BATCH = 2
SEQ = 8192
DEPTH = 1

GM_WIDTH = D_MODEL
GM_GROUPS = 8
GM_GROUP_DIM = GM_WIDTH // GM_GROUPS
GM_CHUNK = 128
N_HEADS = 8
N_KV_HEADS = 2
Q_PER_KV = N_HEADS // N_KV_HEADS
HEAD_DIM = 128
ATTN_WIDTH = N_HEADS * HEAD_DIM
KV_WIDTH = N_KV_HEADS * HEAD_DIM
CMP_BLOCK = 32
CMP_STRIDE = 16
SEL_BLOCK = 64
N_SELECT = 16
N_LOCAL_FORCED = 2
WINDOW = 512
Q_BLOCK = 128
N_NSA_BRANCH = 3
N_MERGE_BRANCH = 2
D_FF = 4 * D_MODEL
SPLIT_SIZES = (2 * GM_WIDTH, ATTN_WIDTH, KV_WIDTH, KV_WIDTH, KV_WIDTH, KV_WIDTH, KV_WIDTH, KV_WIDTH,
               N_NSA_BRANCH * N_HEADS, N_MERGE_BRANCH * D_MODEL)
D_IN = sum(SPLIT_SIZES)
DEEPNORM_ALPHA = (2.0 * DEPTH) ** 0.25
DEEPNORM_BETA = (8.0 * DEPTH) ** -0.25
LN_EPS = 1e-5
NEG_INF = -1e30
FORCED_SCORE = 1e9

kernel_name = "gmlp_nsa_griffin_merge_deepnorm"


def layer_norm(x, g, b):
    xf = x.astype(jnp.float32)
    mu = jnp.mean(xf, axis=-1, keepdims=True)
    var = jnp.mean(jnp.square(xf - mu), axis=-1, keepdims=True)
    y = (xf - mu) * lax.rsqrt(var + LN_EPS) * g.astype(jnp.float32) + b.astype(jnp.float32)
    return y.astype(x.dtype)


def alibi_slopes():
    h = jnp.arange(1, N_HEADS + 1, dtype=jnp.float32)
    return (2.0 ** (-8.0 * h / N_HEADS)).reshape(N_KV_HEADS, Q_PER_KV)


def spatial_gating(z, ln_g, ln_b, w_s, b_s):
    bsz, seq, _ = z.shape
    u, v = jnp.split(jax.nn.gelu(z), 2, axis=-1)
    v = layer_norm(v, ln_g, ln_b).reshape(bsz, seq // GM_CHUNK, GM_CHUNK, GM_GROUPS, GM_GROUP_DIM)
    causal = jnp.tril(jnp.ones((GM_CHUNK, GM_CHUNK), dtype=w_s.dtype))
    v = jnp.einsum("gij,bnjgd->bnigd", w_s * causal, v) + b_s.T[None, None, :, :, None]
    return u * v.reshape(bsz, seq, GM_WIDTH)


def compress(x, pe, w1, w2):
    bsz, seq = x.shape[:2]
    ch = x.reshape(bsz, seq // CMP_STRIDE, CMP_STRIDE, N_KV_HEADS, HEAD_DIM)
    blk = jnp.concatenate([ch[:, :-1], ch[:, 1:]], axis=2) + pe[None, None, :, None, :]
    flat = blk.transpose(0, 1, 3, 2, 4).reshape(bsz, seq // CMP_STRIDE - 1, N_KV_HEADS, CMP_BLOCK * HEAD_DIM)
    return jax.nn.gelu(flat @ w1) @ w2


def nsa_attention(q, k_cmp, v_cmp, k_slc, v_slc, k_win, v_win, gates):
    bsz, seq = q.shape[:2]
    n_cmp = seq // CMP_STRIDE - 1
    n_sel = seq // SEL_BLOCK
    k_top = min(N_SELECT, n_sel)
    slopes = alibi_slopes()
    q = (q * HEAD_DIM ** -0.5).reshape(bsz, seq, N_KV_HEADS, Q_PER_KV, HEAD_DIM)
    gates = gates.reshape(bsz, seq, N_KV_HEADS, Q_PER_KV, N_NSA_BRANCH)
    cmp_idx = jnp.arange(n_cmp)
    cmp_end = cmp_idx * CMP_STRIDE + CMP_BLOCK - 1
    cmp_ctr = cmp_idx.astype(jnp.float32) * CMP_STRIDE + 0.5 * (CMP_BLOCK - 1)
    sel_idx = jnp.arange(n_sel)
    overlap = ((cmp_end[:, None] >= sel_idx[None, :] * SEL_BLOCK)
               & (cmp_idx[:, None] * CMP_STRIDE <= sel_idx[None, :] * SEL_BLOCK + SEL_BLOCK - 1)).astype(jnp.float32)
    ks_blocks = k_slc.reshape(bsz, n_sel, SEL_BLOCK, N_KV_HEADS, HEAD_DIM).transpose(0, 3, 1, 2, 4)
    vs_blocks = v_slc.reshape(bsz, n_sel, SEL_BLOCK, N_KV_HEADS, HEAD_DIM).transpose(0, 3, 1, 2, 4)
    pad = ((0, 0), (WINDOW, 0), (0, 0), (0, 0))
    kw_pad = jnp.pad(k_win, pad)
    vw_pad = jnp.pad(v_win, pad)
    gather = jax.vmap(jax.vmap(lambda blocks, ix: blocks[ix]))
    offs_sel = jnp.arange(SEL_BLOCK)
    offs_win = jnp.arange(WINDOW + Q_BLOCK)

    def query_block(qb):
        q0 = qb * Q_BLOCK
        qc = lax.dynamic_slice_in_dim(q, q0, Q_BLOCK, axis=1)
        gc = lax.dynamic_slice_in_dim(gates, q0, Q_BLOCK, axis=1)
        t = q0 + jnp.arange(Q_BLOCK)
        valid_c = cmp_end[None, :] <= t[:, None]
        dist_c = t[:, None].astype(jnp.float32) - cmp_ctr[None, :]
        s = jnp.einsum("bqhgd,bnhd->bhgqn", qc, k_cmp).astype(jnp.float32) \
            - slopes[None, :, :, None, None] * dist_c
        p_c = jnp.where(valid_c, jax.nn.softmax(jnp.where(valid_c, s, NEG_INF), axis=-1), 0.0)
        o_c = jnp.einsum("bhgqn,bnhd->bqhgd", p_c.astype(v_cmp.dtype), v_cmp)
        imp = jnp.einsum("bhgqn,nm->bhqm", p_c, overlap)
        lag = (t // SEL_BLOCK)[:, None] - sel_idx[None, :]
        forced = (sel_idx[None, :] == 0) | ((lag >= 0) & (lag < N_LOCAL_FORCED))
        score = jnp.where(forced, FORCED_SCORE, jnp.where(lag >= 0, imp, -1.0))
        _, idx = lax.top_k(score, k_top)
        ks = gather(ks_blocks, idx)
        vs = gather(vs_blocks, idx)
        dist_s = (t[None, None, :, None, None] - (idx[..., None] * SEL_BLOCK + offs_sel))[:, :, None]
        s = jnp.einsum("bqhgd,bhqnkd->bhgqnk", qc, ks).astype(jnp.float32) \
            - slopes[None, :, :, None, None, None] * dist_s.astype(jnp.float32)
        s = jnp.where(dist_s >= 0, s, NEG_INF)
        shp = s.shape
        p_s = jax.nn.softmax(s.reshape(shp[0], shp[1], shp[2], shp[3], -1), axis=-1).reshape(shp)
        o_s = jnp.einsum("bhgqnk,bhqnkd->bqhgd", p_s.astype(vs.dtype), vs)
        kw = lax.dynamic_slice_in_dim(kw_pad, q0, WINDOW + Q_BLOCK, axis=1)
        vw = lax.dynamic_slice_in_dim(vw_pad, q0, WINDOW + Q_BLOCK, axis=1)
        dist_w = t[:, None] - (q0 - WINDOW + offs_win)[None, :]
        valid_w = (dist_w >= 0) & (dist_w < WINDOW) & (dist_w <= t[:, None])
        s = jnp.einsum("bqhgd,bkhd->bhgqk", qc, kw).astype(jnp.float32) \
            - slopes[None, :, :, None, None] * dist_w.astype(jnp.float32)
        p_w = jax.nn.softmax(jnp.where(valid_w, s, NEG_INF), axis=-1)
        o_w = jnp.einsum("bhgqk,bkhd->bqhgd", p_w.astype(vw.dtype), vw)
        return gc[..., 0:1] * o_c + gc[..., 1:2] * o_s + gc[..., 2:3] * o_w

    out = lax.map(query_block, jnp.arange(seq // Q_BLOCK))
    return jnp.moveaxis(out, 0, 1).reshape(bsz, seq, ATTN_WIDTH)


def setup_inputs(seed: int = 0) -> dict:
    key = jax.random.key(seed)
    ks = jax.random.split(key, 24)

    def nrm(k, shape, scale):
        return jax.random.normal(k, shape, jnp.float32) * scale

    L = DEPTH
    fan_cmp = CMP_BLOCK * HEAD_DIM
    return {
        "x": nrm(ks[0], (BATCH, SEQ, D_MODEL), 1.0),
        "w_in": nrm(ks[1], (L, D_MODEL, D_IN), D_MODEL ** -0.5),
        "gm_ln_g": 1.0 + nrm(ks[2], (L, GM_WIDTH), 0.02),
        "gm_ln_b": nrm(ks[3], (L, GM_WIDTH), 0.02),
        "gm_w_s": nrm(ks[4], (L, GM_GROUPS, GM_CHUNK, GM_CHUNK), GM_CHUNK ** -0.5),
        "gm_b_s": 1.0 + nrm(ks[5], (L, GM_GROUPS, GM_CHUNK), 0.02),
        "cmp_pe_k": nrm(ks[6], (L, CMP_BLOCK, HEAD_DIM), 0.02),
        "cmp_w1_k": nrm(ks[7], (L, fan_cmp, HEAD_DIM), fan_cmp ** -0.5),
        "cmp_w2_k": nrm(ks[8], (L, HEAD_DIM, HEAD_DIM), HEAD_DIM ** -0.5),
        "cmp_pe_v": nrm(ks[9], (L, CMP_BLOCK, HEAD_DIM), 0.02),
        "cmp_w1_v": nrm(ks[10], (L, fan_cmp, HEAD_DIM), fan_cmp ** -0.5),
        "cmp_w2_v": nrm(ks[11], (L, HEAD_DIM, HEAD_DIM), HEAD_DIM ** -0.5),
        "w_proj_gm": nrm(ks[12], (L, GM_WIDTH, D_MODEL), GM_WIDTH ** -0.5 * DEEPNORM_BETA),
        "w_proj_nsa": nrm(ks[13], (L, ATTN_WIDTH, D_MODEL), ATTN_WIDTH ** -0.5 * DEEPNORM_BETA),
        "w_out": nrm(ks[14], (L, D_MODEL, D_MODEL), D_MODEL ** -0.5 * DEEPNORM_BETA),
        "ln1_g": 1.0 + nrm(ks[15], (L, D_MODEL), 0.02),
        "ln1_b": nrm(ks[16], (L, D_MODEL), 0.02),
        "w_ff1": nrm(ks[17], (L, D_MODEL, D_FF), D_MODEL ** -0.5),
        "w_ff2": nrm(ks[18], (L, D_FF, D_MODEL), D_FF ** -0.5 * DEEPNORM_BETA),
        "ln2_g": 1.0 + nrm(ks[19], (L, D_MODEL), 0.02),
        "ln2_b": nrm(ks[20], (L, D_MODEL), 0.02),
    }


def reference(x, w_in, gm_ln_g, gm_ln_b, gm_w_s, gm_b_s, cmp_pe_k, cmp_w1_k, cmp_w2_k,
              cmp_pe_v, cmp_w1_v, cmp_w2_v, w_proj_gm, w_proj_nsa, w_out,
              ln1_g, ln1_b, w_ff1, w_ff2, ln2_g, ln2_b):
    bsz, seq, _ = x.shape
    split_points = np.cumsum(SPLIT_SIZES)[:-1].tolist()
    kv_shape = (bsz, seq, N_KV_HEADS, HEAD_DIM)
    h = x
    for l in range(DEPTH):
        z = h @ w_in[l]
        (z_gm, z_q, z_kc, z_vc, z_ks, z_vs, z_kw, z_vw, z_g, z_m) = jnp.split(z, split_points, axis=-1)
        y_gm = spatial_gating(z_gm, gm_ln_g[l], gm_ln_b[l], gm_w_s[l], gm_b_s[l])
        k_cmp = compress(z_kc.reshape(kv_shape), cmp_pe_k[l], cmp_w1_k[l], cmp_w2_k[l])
        v_cmp = compress(z_vc.reshape(kv_shape), cmp_pe_v[l], cmp_w1_v[l], cmp_w2_v[l])
        y_nsa = nsa_attention(z_q, k_cmp, v_cmp, z_ks.reshape(kv_shape), z_vs.reshape(kv_shape),
                              z_kw.reshape(kv_shape), z_vw.reshape(kv_shape), jax.nn.sigmoid(z_g))
        mg = jax.nn.sigmoid(z_m).reshape(bsz, seq, N_MERGE_BRANCH, D_MODEL)
        mix = (mg[:, :, 0] * (y_gm @ w_proj_gm[l]) + mg[:, :, 1] * (y_nsa @ w_proj_nsa[l])) @ w_out[l]
        h = layer_norm(DEEPNORM_ALPHA * h + mix, ln1_g[l], ln1_b[l])
        f = jnp.square(jax.nn.relu(h @ w_ff1[l])) @ w_ff2[l]
        h = layer_norm(DEEPNORM_ALPHA * h + f, ln2_g[l], ln2_b[l])
    return h
```

```cpp
#include <hip/hip_runtime.h>
#include <hip/hip_cooperative_groups.h>
#include <cstdio>
#include <cstdint>
namespace cg = cooperative_groups;

constexpr int D = 1024, SEQ = 8192, BATCH = 2, DIN = 6680, DFF = 4096;
constexpr int C_U = 0, C_V = 1024, C_Q = 2048, C_KC = 3072, C_VC = 3328, C_KS = 3584, C_VS = 3840, C_KW = 4096, C_VW = 4352, C_G = 4608, C_M = 4632;
constexpr int NCMP = 511, NSEL = 128;
constexpr float ALPHA = 1.189207115002721f;
constexpr float LN_EPS = 1e-5f;
constexpr int LDS_BYTES = 147456;
constexpr int NT = 512;

struct Params {
  const float* x; const float* w_in; const float* gm_ln_g; const float* gm_ln_b; const float* gm_w_s; const float* gm_b_s;
  const float* pe_k; const float* w1_k; const float* w2_k; const float* pe_v; const float* w1_v; const float* w2_v;
  const float* w_pgm; const float* w_pnsa; const float* w_out; const float* ln1_g; const float* ln1_b;
  const float* w_ff1; const float* w_ff2; const float* ln2_g; const float* ln2_b;
  float* out; unsigned char* ws;
};

__device__ __forceinline__ int tid_l() { int t = threadIdx.x; asm volatile("" : "+v"(t)); return t; }
__device__ __forceinline__ int bid_l() { int t = blockIdx.x; asm volatile("" : "+s"(t)); return t; }
__device__ __forceinline__ float wave_sum(float v) {
#pragma unroll
  for (int o = 1; o < 64; o <<= 1) v += __shfl_xor(v, o);
  return v;
}
__device__ __forceinline__ float wave_max(float v) {
#pragma unroll
  for (int o = 1; o < 64; o <<= 1) v = fmaxf(v, __shfl_xor(v, o));
  return v;
}
__device__ __forceinline__ float gelu_tanh(float x) {
  const float c = 0.7978845608028654f;
  return 0.5f * x * (1.0f + tanhf(c * (x + 0.044715f * x * x * x)));
}
__device__ __forceinline__ float sigmoidf_(float x) { return 1.0f / (1.0f + expf(-x)); }

template <int MODE>
__device__ void sgemm_phase(float* lds, const float* A, int lda, const float* B, int ldb, float* C, int ldc, int M, int N, int K,
                            const float* aux, int ldaux) {
  const int tid = tid_l(), bid = bid_l(), tx = tid & 31, ty = tid >> 5;
  float* As = lds;
  float* Bs = lds + 16 * 132;
  const int nM = M / 128, nN = (N + 127) / 128;
  for (int tile = bid; tile < nM * nN; tile += gridDim.x) {
    const int tm = tile % nM, tn = tile / nM;
    const int m0 = tm * 128, n0 = tn * 128;
    float acc[8][4];
#pragma unroll
    for (int i = 0; i < 8; ++i)
#pragma unroll
      for (int j = 0; j < 4; ++j) acc[i][j] = 0.f;
    for (int k0 = 0; k0 < K; k0 += 16) {
      {
        const int r = tid >> 2, kq = (tid & 3) * 4;
        const float4 a = *(const float4*)(A + (size_t)(m0 + r) * lda + k0 + kq);
        As[(kq + 0) * 132 + r] = a.x; As[(kq + 1) * 132 + r] = a.y; As[(kq + 2) * 132 + r] = a.z; As[(kq + 3) * 132 + r] = a.w;
      }
      {
        const int k = tid >> 5, nq = (tid & 31) * 4;
        float4 b = make_float4(0.f, 0.f, 0.f, 0.f);
        if (n0 + nq < N) b = *(const float4*)(B + (size_t)(k0 + k) * ldb + n0 + nq);
        *(float4*)(Bs + k * 128 + nq) = b;
      }
      __syncthreads();
#pragma unroll
      for (int k = 0; k < 16; ++k) {
        const float4 a0 = *(const float4*)(As + k * 132 + ty * 8), a1 = *(const float4*)(As + k * 132 + ty * 8 + 4);
        const float4 b = *(const float4*)(Bs + k * 128 + tx * 4);
        const float av[8] = {a0.x, a0.y, a0.z, a0.w, a1.x, a1.y, a1.z, a1.w};
        const float bv[4] = {b.x, b.y, b.z, b.w};
#pragma unroll
        for (int i = 0; i < 8; ++i)
#pragma unroll
          for (int j = 0; j < 4; ++j) acc[i][j] = fmaf(av[i], bv[j], acc[i][j]);
      }
      __syncthreads();
    }
#pragma unroll
    for (int i = 0; i < 8; ++i) {
      const int row = m0 + ty * 8 + i;
#pragma unroll
      for (int j = 0; j < 4; ++j) {
        const int col = n0 + tx * 4 + j;
        if (col < N) {
          float v = acc[i][j];
          float* cp = C + (size_t)row * ldc + col;
          if (MODE == 1) v = sigmoidf_(aux[(size_t)row * ldaux + col]) * v;
          if (MODE == 2) v = *cp + sigmoidf_(aux[(size_t)row * ldaux + col]) * v;
          if (MODE == 3) v = ALPHA * aux[(size_t)row * ldaux + col] + v;
          if (MODE == 4) { v = fmaxf(v, 0.f); v = v * v; }
          *cp = v;
        }
      }
    }
  }
}

__device__ void gelu_stats_phase(float* Z, int M, float* stats) {
  const int tid = tid_l(), lane = tid & 63, gw = bid_l() * (NT / 64) + (tid >> 6), ngw = gridDim.x * (NT / 64);
  for (int r = gw; r < M; r += ngw) {
    float* z = Z + (size_t)r * DIN;
    for (int c = lane; c < 1024; c += 64) z[c] = gelu_tanh(z[c]);
    float vv[16]; float s = 0.f;
#pragma unroll
    for (int i = 0; i < 16; ++i) { const float g = gelu_tanh(z[1024 + lane + 64 * i]); vv[i] = g; z[1024 + lane + 64 * i] = g; s += g; }
    const float mu = wave_sum(s) * (1.f / 1024.f);
    float q = 0.f;
#pragma unroll
    for (int i = 0; i < 16; ++i) { const float d = vv[i] - mu; q += d * d; }
    const float var = wave_sum(q) * (1.f / 1024.f);
    if (lane == 0) { stats[2 * r] = mu; stats[2 * r + 1] = 1.0f / sqrtf(var + LN_EPS); }
  }
}

__device__ void ln_rows_phase(float* X, int M, const float* g, const float* b) {
  const int tid = tid_l(), lane = tid & 63, gw = bid_l() * (NT / 64) + (tid >> 6), ngw = gridDim.x * (NT / 64);
  for (int r = gw; r < M; r += ngw) {
    float* x = X + (size_t)r * D;
    float vv[16]; float s = 0.f;
#pragma unroll
    for (int i = 0; i < 16; ++i) { vv[i] = x[lane + 64 * i]; s += vv[i]; }
    const float mu = wave_sum(s) * (1.f / 1024.f);
    float q = 0.f;
#pragma unroll
    for (int i = 0; i < 16; ++i) { const float d = vv[i] - mu; q += d * d; }
    const float rstd = 1.0f / sqrtf(wave_sum(q) * (1.f / 1024.f) + LN_EPS);
#pragma unroll
    for (int i = 0; i < 16; ++i) { const int c = lane + 64 * i; x[c] = (vv[i] - mu) * rstd * g[c] + b[c]; }
  }
}

__device__ void gmlp_phase(float* lds, float* Z, int M, const float* stats, const Params& p) {
  const int tid = tid_l(), bid = bid_l();
  float* lv = lds;
  const int nitems = (M / 128) * 8;
  for (int it = bid; it < nitems; it += gridDim.x) {
    const int n = it >> 3, g = it & 7;
    const int r0 = n * 128, c0 = g * 128;
    for (int e = tid; e < 128 * 128; e += NT) {
      const int j = e >> 7, d = e & 127;
      const float v = Z[(size_t)(r0 + j) * DIN + C_V + c0 + d];
      lv[e] = (v - stats[2 * (r0 + j)]) * stats[2 * (r0 + j) + 1] * p.gm_ln_g[c0 + d] + p.gm_ln_b[c0 + d];
    }
    __syncthreads();
    const int i = tid >> 2, dq = (tid & 3) * 32;
    float acc[32];
#pragma unroll
    for (int e = 0; e < 32; ++e) acc[e] = 0.f;
    const float* wrow = p.gm_w_s + ((size_t)g * 128 + i) * 128;
    for (int j = 0; j <= i; ++j) {
      const float w = wrow[j];
#pragma unroll
      for (int e = 0; e < 32; ++e) acc[e] = fmaf(w, lv[j * 128 + dq + e], acc[e]);
    }
    const float bs = p.gm_b_s[g * 128 + i];
    float* urow = Z + (size_t)(r0 + i) * DIN + C_U + c0 + dq;
#pragma unroll
    for (int e = 0; e < 32; ++e) urow[e] = urow[e] * (acc[e] + bs);
    __syncthreads();
  }
}

__device__ void compress_phase(float* lds, const float* Z, float* KC, float* VC, const Params& p) {
  const int tid = tid_l(), bid = bid_l(), sub = tid >> 7, t = tid & 127;
  float* flat = lds + sub * (4096 + 128);
  float* hid = flat + 4096;
  const int nitems = NCMP * 2 * 2;
  const int nrounds = (nitems + 3) / 4;
  for (int rd = bid; rd < nrounds; rd += gridDim.x) {
    const int it = rd * 4 + sub;
    const bool ok = it < nitems;
    const int which = ok ? it / (NCMP * 2) : 0, rem = ok ? it % (NCMP * 2) : 0, i = rem >> 1, h = rem & 1;
    const float* pe = which ? p.pe_v : p.pe_k; const float* w1 = which ? p.w1_v : p.w1_k; const float* w2 = which ? p.w2_v : p.w2_k;
    const int ccol = (which ? C_VC : C_KC) + h * 128;
    for (int e = t; e < 4096; e += 128) { const int pp = e >> 7, d = e & 127; flat[e] = Z[(size_t)(16 * i + pp) * DIN + ccol + d] + pe[pp * 128 + d]; }
    __syncthreads();
    float a = 0.f;
    for (int k = 0; k < 4096; ++k) a = fmaf(flat[k], w1[(size_t)k * 128 + t], a);
    hid[t] = gelu_tanh(a);
    __syncthreads();
    float o = 0.f;
    for (int k = 0; k < 128; ++k) o = fmaf(hid[k], w2[k * 128 + t], o);
    if (ok) (which ? VC : KC)[((size_t)i * 2 + h) * 128 + t] = o;
    __syncthreads();
  }
}

__device__ __forceinline__ float dot128(const float* q, const float* k) {
  float a = 0.f;
#pragma unroll 8
  for (int d = 0; d < 128; d += 4) { const float4 kv = *(const float4*)(k + d); a = fmaf(q[d], kv.x, a); a = fmaf(q[d + 1], kv.y, a); a = fmaf(q[d + 2], kv.z, a); a = fmaf(q[d + 3], kv.w, a); }
  return a;
}
constexpr int ATT_SUB_FLOATS = 4 * 128 + 4 * 512 + 4 * 1024 + 4 * 512 + 128 + 4 * 16;
__device__ void attn_phase(float* lds, float* Z, int M, const float* KC, const float* VC) {
  const int tid = tid_l(), bid = bid_l(), sub = tid >> 8, w = (tid >> 6) & 3, lane = tid & 63, st = tid & 255;
  float* base = lds + sub * ATT_SUB_FLOATS;
  float* qs = base;
  float* pc = qs + 4 * 128;
  float* ps = pc + 4 * 512;
  float* pw = ps + 4 * 1024;
  float* imp = pw + 4 * 512;
  int* sel = (int*)(imp + 128);
  const int nunits = M * 2;
  for (int u0 = bid * 2; u0 < nunits; u0 += gridDim.x * 2) {
    const int u = u0 + sub;
    const int t = u >> 1, kv = u & 1, head = kv * 4 + w;
    const float slope = exp2f(-(float)(head + 1));
    float* zrow = Z + (size_t)t * DIN;
    qs[w * 128 + lane] = zrow[C_Q + head * 128 + lane] * 0.08838834764831845f;
    qs[w * 128 + lane + 64] = zrow[C_Q + head * 128 + lane + 64] * 0.08838834764831845f;
    const float g0 = sigmoidf_(zrow[C_G + head * 3 + 0]), g1 = sigmoidf_(zrow[C_G + head * 3 + 1]), g2 = sigmoidf_(zrow[C_G + head * 3 + 2]);
    __syncthreads();
    const float* q = qs + w * 128;
    const int ncv = t >= 31 ? min((t - 31) / 16 + 1, NCMP) : 0;
    float sc[8]; float mx = -1e30f;
#pragma unroll
    for (int i = 0; i < 8; ++i) {
      const int n = lane + 64 * i;
      float s = -1e30f;
      if (n < ncv) s = dot128(q, KC + ((size_t)n * 2 + kv) * 128) - slope * ((float)t - ((float)n * 16.f + 15.5f));
      sc[i] = s; mx = fmaxf(mx, s);
    }
    mx = wave_max(mx);
    float sum = 0.f;
#pragma unroll
    for (int i = 0; i < 8; ++i) { const int n = lane + 64 * i; const float e = (n < ncv) ? expf(sc[i] - mx) : 0.f; sc[i] = e; sum += e; }
    sum = wave_sum(sum);
    const float inv = ncv > 0 ? 1.0f / sum : 0.f;
#pragma unroll
    for (int i = 0; i < 8; ++i) pc[w * 512 + lane + 64 * i] = sc[i] * inv;
    __syncthreads();
    float oc0 = 0.f, oc1 = 0.f;
    for (int n = 0; n < ncv; ++n) { const float pr = pc[w * 512 + n]; const float* vr = VC + ((size_t)n * 2 + kv) * 128; oc0 = fmaf(pr, vr[lane], oc0); oc1 = fmaf(pr, vr[lane + 64], oc1); }
    if (st < 128) {
      const int m = st; float a = 0.f;
      for (int g = 0; g < 4; ++g)
        for (int n = 4 * m - 1; n <= 4 * m + 3; ++n) if (n >= 0 && n < NCMP) a += pc[g * 512 + n];
      const int lag = (t >> 6) - m;
      const bool forced = (m == 0) || (lag >= 0 && lag < 2);
      imp[m] = forced ? 1e9f : (lag >= 0 ? a : -1.0f);
    }
    __syncthreads();
    {
      float v0 = imp[lane], v1 = imp[lane + 64];
      for (int r = 0; r < 16; ++r) {
        float best; int bi;
        if (v0 >= v1) { best = v0; bi = lane; } else { best = v1; bi = lane + 64; }
#pragma unroll
        for (int o = 1; o < 64; o <<= 1) {
          const float ov = __shfl_xor(best, o); const int oi = __shfl_xor(bi, o);
          if (ov > best || (ov == best && oi < bi)) { best = ov; bi = oi; }
        }
        if (lane == 0) sel[w * 16 + r] = bi;
        if (bi == lane) v0 = -3e38f;
        if (bi == lane + 64) v1 = -3e38f;
      }
    }
    __syncthreads();
    float mxs = -1e30f;
    for (int r = 0; r < 16; ++r) {
      const int blk = sel[w * 16 + r]; const int pos = blk * 64 + lane; const int dist = t - pos;
      float s = -1e30f;
      if (dist >= 0) s = dot128(q, Z + (size_t)pos * DIN + C_KS + kv * 128) - slope * (float)dist;
      ps[w * 1024 + r * 64 + lane] = s; mxs = fmaxf(mxs, s);
    }
    mxs = wave_max(mxs);
    float sums = 0.f;
    for (int r = 0; r < 16; ++r) { const float s = ps[w * 1024 + r * 64 + lane]; const float e = (s > -1e29f) ? expf(s - mxs) : 0.f; ps[w * 1024 + r * 64 + lane] = e; sums += e; }
    sums = wave_sum(sums);
    const float invs = 1.0f / sums;
    __syncthreads();
    float os0 = 0.f, os1 = 0.f;
    for (int r = 0; r < 16; ++r) {
      const int blk = sel[w * 16 + r];
      for (int k = 0; k < 64; ++k) {
        const float pr = ps[w * 1024 + r * 64 + k];
        if (pr != 0.f) { const float* vr = Z + (size_t)(blk * 64 + k) * DIN + C_VS + kv * 128; os0 = fmaf(pr, vr[lane], os0); os1 = fmaf(pr, vr[lane + 64], os1); }
      }
    }
    os0 *= invs; os1 *= invs;
    float mxw = -1e30f;
#pragma unroll
    for (int i = 0; i < 8; ++i) {
      const int j = lane + 64 * i; const int pos = t - 511 + j;
      float s = -1e30f;
      if (pos >= 0) s = dot128(q, Z + (size_t)pos * DIN + C_KW + kv * 128) - slope * (float)(t - pos);
      sc[i] = s; mxw = fmaxf(mxw, s);
    }
    mxw = wave_max(mxw);
    float sumw = 0.f;
#pragma unroll
    for (int i = 0; i < 8; ++i) { const int pos = t - 511 + lane + 64 * i; const float e = (pos >= 0) ? expf(sc[i] - mxw) : 0.f; pw[w * 512 + lane + 64 * i] = e; sumw += e; }
    sumw = wave_sum(sumw);
    const float invw = 1.0f / sumw;
    __syncthreads();
    float ow0 = 0.f, ow1 = 0.f;
    for (int j = 0; j < 512; ++j) {
      const int pos = t - 511 + j;
      if (pos >= 0) { const float pr = pw[w * 512 + j]; const float* vr = Z + (size_t)pos * DIN + C_VW + kv * 128; ow0 = fmaf(pr, vr[lane], ow0); ow1 = fmaf(pr, vr[lane + 64], ow1); }
    }
    ow0 *= invw; ow1 *= invw;
    zrow[C_Q + head * 128 + lane] = g0 * oc0 + g1 * os0 + g2 * ow0;
    zrow[C_Q + head * 128 + lane + 64] = g0 * oc1 + g1 * os1 + g2 * ow1;
    __syncthreads();
  }
}

__global__ void __launch_bounds__(NT, 2) fwd_megakernel(Params p) {
  extern __shared__ __attribute__((aligned(16))) unsigned char lds_raw[];
  float* lds = (float*)lds_raw;
  cg::grid_group grid = cg::this_grid();
  constexpr int M = SEQ;
  float* Z = (float*)p.ws;
  float* KC = Z + (size_t)M * DIN;
  float* VC = KC + NCMP * 2 * 128;
  float* stats = VC + NCMP * 2 * 128;
  float* T1 = stats + 2 * M;
#pragma unroll 1
  for (int b = 0; b < BATCH; ++b) {
    const float* xb = p.x + (size_t)b * M * D;
    float* ob = p.out + (size_t)b * M * D;
    sgemm_phase<0>(lds, xb, D, p.w_in, DIN, Z, DIN, M, DIN, D, nullptr, 0);
    grid.sync();
    gelu_stats_phase(Z, M, stats);
    grid.sync();
    gmlp_phase(lds, Z, M, stats, p);
    compress_phase(lds, Z, KC, VC, p);
    grid.sync();
    attn_phase(lds, Z, M, KC, VC);
    grid.sync();
    sgemm_phase<1>(lds, Z + C_U, DIN, p.w_pgm, D, Z + C_V, DIN, M, D, D, Z + C_M, DIN);
    grid.sync();
    sgemm_phase<2>(lds, Z + C_Q, DIN, p.w_pnsa, D, Z + C_V, DIN, M, D, D, Z + C_M + D, DIN);
    grid.sync();
    sgemm_phase<3>(lds, Z + C_V, DIN, p.w_out, D, T1, D, M, D, D, xb, D);
    grid.sync();
    ln_rows_phase(T1, M, p.ln1_g, p.ln1_b);
    grid.sync();
    sgemm_phase<4>(lds, T1, D, p.w_ff1, DFF, Z, DFF, M, DFF, D, nullptr, 0);
    grid.sync();
    sgemm_phase<3>(lds, Z, DFF, p.w_ff2, D, ob, D, M, D, DFF, T1, D);
    grid.sync();
    ln_rows_phase(ob, M, p.ln2_g, p.ln2_b);
    grid.sync();
  }
}

extern "C" void kernel_launch(void* const* d_in, const int* in_sizes, int n_in,
                              void* d_out, int out_size, void* d_ws, size_t ws_size,
                              hipStream_t stream) {
  static int grid_blocks = 0;
  if (!grid_blocks) {
    int dev = 0, cus = 0, per_cu = 0;
    (void)hipGetDevice(&dev);
    (void)hipDeviceGetAttribute(&cus, hipDeviceAttributeMultiprocessorCount, dev);
    (void)hipFuncSetAttribute((const void*)fwd_megakernel, hipFuncAttributeMaxDynamicSharedMemorySize, LDS_BYTES);
    (void)hipOccupancyMaxActiveBlocksPerMultiprocessor(&per_cu, (const void*)fwd_megakernel, NT, LDS_BYTES);
    if (per_cu < 1) per_cu = 1;
    grid_blocks = cus;
  }
  Params p{};
  const float* const* in = (const float* const*)d_in;
  p.x = in[0]; p.w_in = in[1]; p.gm_ln_g = in[2]; p.gm_ln_b = in[3]; p.gm_w_s = in[4]; p.gm_b_s = in[5];
  p.pe_k = in[6]; p.w1_k = in[7]; p.w2_k = in[8]; p.pe_v = in[9]; p.w1_v = in[10]; p.w2_v = in[11];
  p.w_pgm = in[12]; p.w_pnsa = in[13]; p.w_out = in[14]; p.ln1_g = in[15]; p.ln1_b = in[16];
  p.w_ff1 = in[17]; p.w_ff2 = in[18]; p.ln2_g = in[19]; p.ln2_b = in[20];
  p.out = (float*)d_out; p.ws = (unsigned char*)d_ws;
  void* args[] = {&p};
  hipError_t e = hipLaunchCooperativeKernel((const void*)fwd_megakernel, dim3(grid_blocks), dim3(NT), args, LDS_BYTES, stream);
  if (e != hipSuccess) fprintf(stderr, "cooperative launch failed: %s (grid %d)\n", hipGetErrorString(e), grid_blocks);
}
```

```cpp
#define N_LAUNCH_SPLIT 0
#include <hip/hip_runtime.h>
#include <hip/hip_cooperative_groups.h>
#include <cstdio>
#include <cstdint>
namespace cg = cooperative_groups;
namespace pg8 {
#define PG8_LAS __attribute__((address_space(3)))
typedef unsigned short bf16_t;
typedef short bf16x8 __attribute__((ext_vector_type(8)));
typedef float f32x4 __attribute__((ext_vector_type(4)));
typedef unsigned u32x4 __attribute__((ext_vector_type(4)));
constexpr int BM = 256, BK = 64, HALF = 128, HTB = HALF * BK * 2  , STAGE_BYTES = 8 * HTB, NXCD = 8, WGM = 8;

__host__ __device__ __forceinline__ int lds_byte(int r, int c) { const int st = (r >> 4) * 2 + (c >> 5), rr = r & 15, cc = c & 31, ob = rr * 64 + cc * 2; return st * 1024 + (ob ^ (((ob >> 9) & 1) << 5)); }
__host__ __device__ __forceinline__ void stage_rc(int b, int& R, int& C) { const int st = b / 1024, sb = b % 1024, swz = sb ^ (((sb >> 9) & 1) << 5); R = (st >> 1) * 16 + swz / 64; C = (st & 1) * 32 + (swz % 64) / 2; }
__host__ __device__ __forceinline__ int perm32(int rho) { const int n = rho >> 4, i = rho & 15; return 8 * (i >> 2) + 4 * n + (i & 3); }

struct Unit { int pm, pn; };
struct Gemm { const bf16_t* A; const bf16_t* Bt; int M, N, K; };

struct StaticOrder {
    int nM, nN, nwg, G, c;
    __host__ __device__ void init(int M, int N, int G_, int c_) { nM = M / BM; nN = N / BM; nwg = nM * nN; G = G_; c = c_; }
    __host__ __device__ bool next(int i, Unit& u) const {
        const long L = (long)i * G + c; if (L >= nwg) return false;
        int wgid = (int)L; { const int q = nwg / NXCD, r = nwg % NXCD, xcd = wgid % NXCD, off = wgid / NXCD; wgid = (xcd < r ? xcd * (q + 1) : r * (q + 1) + (xcd - r) * q) + off; }
        const int nig = WGM * nN, gid = wgid / nig, fm = gid * WGM, gsz = (nM - fm) < WGM ? (nM - fm) : WGM;
        u.pm = fm + ((wgid % nig) % gsz); u.pn = (wgid % nig) / gsz; return true;
    }
    __device__ __forceinline__ void a_ready(const Unit&) const {}
    __device__ __forceinline__ void done(const Unit&) const {}
};

__device__ __forceinline__ unsigned cvt_pk_bf16(float lo, float hi) { unsigned r; asm volatile("v_cvt_pk_bf16_f32 %0, %1, %2" : "=v"(r) : "v"(lo), "v"(hi)); return r; }
typedef float f32x2 __attribute__((ext_vector_type(2)));
__device__ __forceinline__ f32x2 gelu_pk(f32x2 v) {
    const f32x2 av = __builtin_elementwise_abs(v), d = av * 0.2316418882f + 1.0f;
    f32x2 t; t.x = __builtin_amdgcn_rcpf(d.x); t.y = __builtin_amdgcn_rcpf(d.y);
    f32x2 q = t * 0.5307027145f + (-0.7265760135f); q = q * t + 0.7107068705f; q = q * t + (-0.142248368f); q = q * t + 0.127414796f; q = q * t;
    const f32x2 s = (v * v) * (-0.72134752044f);
    f32x2 e; e.x = __builtin_amdgcn_exp2f(s.x); e.y = __builtin_amdgcn_exp2f(s.y);
    const f32x2 m = v * (q * e), r = v - m;
    f32x2 o; o.x = v.x < 0.f ? m.x : r.x; o.y = v.y < 0.f ? m.y : r.y; return o;
}

template <int ACT  > struct EpiBf16 {
    static constexpr bool PERM = true, AFTER_DRAIN = false; static_assert(ACT == 0 || ACT == 1, "EpiBf16: ACT is 0 (none) or 1 (gelu_pk)");
    bf16_t* O; int ldc; const float* bias; int split_cols; size_t split_stride; float scale0;
    __device__ __forceinline__ void operator()(const f32x4 (&acc)[2][2][4][2], const Unit& u, int wr, int wc, int fr, int fq) const {
        const int row0 = u.pm * BM + wr * 64 + fr; int colt = u.pn * BM; bf16_t* base = O;
        float sc = 1.f; if (split_cols) { const int t = colt / split_cols; base += (size_t)t * split_stride; colt -= t * split_cols; if (t == 0) sc = scale0; }
        const int col0 = colt + wc * 32 + 8 * fq, bcol0 = u.pn * BM + wc * 32 + 8 * fq;
        f32x4 bv[2][2];
#pragma unroll
        for (int bj = 0; bj < 2; ++bj)
#pragma unroll
            for (int n = 0; n < 2; ++n) bv[bj][n] = bias ? *(const f32x4*)(bias + bcol0 + bj * HALF + 4 * n) : (f32x4){0.f, 0.f, 0.f, 0.f};
#pragma unroll
        for (int ai = 0; ai < 2; ++ai)
#pragma unroll
            for (int m = 0; m < 4; ++m) { bf16_t* rowp = base + (size_t)(row0 + ai * HALF + m * 16) * ldc + col0;
#pragma unroll
                for (int bj = 0; bj < 2; ++bj) { f32x4 v0 = acc[ai][bj][m][0] + bv[bj][0], v1 = acc[ai][bj][m][1] + bv[bj][1];
                    if (ACT == 1) { f32x2 a = gelu_pk((f32x2){v0[0], v0[1]}), b = gelu_pk((f32x2){v0[2], v0[3]}), c = gelu_pk((f32x2){v1[0], v1[1]}), d = gelu_pk((f32x2){v1[2], v1[3]});
                        v0 = (f32x4){a.x, a.y, b.x, b.y}; v1 = (f32x4){c.x, c.y, d.x, d.y}; }
                    v0 = v0 * sc; v1 = v1 * sc; u32x4 w; w.x = cvt_pk_bf16(v0[0], v0[1]); w.y = cvt_pk_bf16(v0[2], v0[3]); w.z = cvt_pk_bf16(v1[0], v1[1]); w.w = cvt_pk_bf16(v1[2], v1[3]);
                    *(u32x4*)(rowp + bj * HALF) = w; } }
    }
};

struct PanelStats {
    unsigned* xbuf;
    unsigned* cnt;
    unsigned* tmo;
    int ntn; float eps;
    unsigned code;
    __device__ __forceinline__ bool run(const f32x4 (&v)[2][2][4][2], const Unit& u, int wr, int wc, int fr, int fq, PG8_LAS unsigned char* lds, int wid, int lane) const {
        typedef float f32x2v __attribute__((ext_vector_type(2)));
        PG8_LAS f32x2v* P = (PG8_LAS f32x2v*)lds;
        PG8_LAS f32x2v* S = (PG8_LAS f32x2v*)(lds + 8192);
        PG8_LAS unsigned* flag = (PG8_LAS unsigned*)(lds + 8192 + 2048);
#pragma unroll
        for (int ai = 0; ai < 2; ++ai)
#pragma unroll
            for (int m = 0; m < 4; ++m) {
                float s = 0.f;
#pragma unroll
                for (int bj = 0; bj < 2; ++bj)
#pragma unroll
                    for (int n = 0; n < 2; ++n) { const f32x4 x = v[ai][bj][m][n]; s += (x[0] + x[1]) + (x[2] + x[3]); }
                s += __shfl_xor(s, 16); s += __shfl_xor(s, 32);
                const float mw = s * (1.0f / 64.0f); float q = 0.f;
#pragma unroll
                for (int bj = 0; bj < 2; ++bj)
#pragma unroll
                    for (int n = 0; n < 2; ++n) { const f32x4 d = v[ai][bj][m][n] - mw; q += (d[0] * d[0] + d[1] * d[1]) + (d[2] * d[2] + d[3] * d[3]); }
                q += __shfl_xor(q, 16); q += __shfl_xor(q, 32);
                if (fq == 0) P[(ai * HALF + wr * 64 + m * 16 + fr) * 4 + wc] = (f32x2v){mw, q};
            }
        asm volatile("s_waitcnt lgkmcnt(0)" ::: "memory"); __builtin_amdgcn_s_barrier(); asm volatile("" ::: "memory");
#if defined(BROKEN_EXCHANGE_NO_WAIT)
#warning BROKEN CONTROL BUILD: the row-statistics exchange does not wait; results are wrong by design
        if (blockIdx.x >= 64) { const long long t0_ = clock64(); while (clock64() - t0_ < 60000) __builtin_amdgcn_s_sleep(8); }
#endif
        const int row = wid * 32 + (lane & 31);
        if (lane < 32) {
            const f32x2v a = P[row * 4 + 0], b = P[row * 4 + 1], c = P[row * 4 + 2], d = P[row * 4 + 3];
            const float mt = (a.x + b.x + c.x + d.x) * 0.25f;
            const float da = a.x - mt, db = b.x - mt, dc = c.x - mt, dd = d.x - mt;
            const float m2 = (a.y + b.y) + (c.y + d.y) + 64.0f * ((da * da + db * db) + (dc * dc + dd * dd));
            unsigned long long* slot = (unsigned long long*)xbuf + ((size_t)(u.pm * BM + row) * 4 + u.pn);
            __hip_atomic_store(slot, ((unsigned long long)__float_as_uint(m2) << 32) | __float_as_uint(mt), __ATOMIC_RELAXED, __HIP_MEMORY_SCOPE_AGENT);
        }
        asm volatile("s_waitcnt vmcnt(0)" ::: "memory");
        if (lane == 0) __hip_atomic_fetch_add(cnt + 64 * u.pm, 1u, __ATOMIC_RELAXED, __HIP_MEMORY_SCOPE_AGENT);
        if (wid == 0) {
            bool dead = false; const unsigned long long t0 = __builtin_amdgcn_s_memrealtime(); const unsigned want = 8u * (unsigned)ntn;
            for (;;) {
#if defined(BROKEN_EXCHANGE_NO_WAIT)
                break;
#endif
                if ((unsigned)__builtin_amdgcn_readfirstlane(__hip_atomic_load(cnt + 64 * u.pm, __ATOMIC_RELAXED, __HIP_MEMORY_SCOPE_AGENT)) >= want) break;
                if (__builtin_amdgcn_s_memrealtime() - t0 > 2000000ull) {
                    if (lane == 0) { unsigned expect = 0u; __hip_atomic_compare_exchange_strong(tmo + 1, &expect, code | (unsigned)(u.pm & 0xff), __ATOMIC_RELAXED, __ATOMIC_RELAXED, __HIP_MEMORY_SCOPE_AGENT);
                                     __hip_atomic_store(tmo, 1u, __ATOMIC_RELAXED, __HIP_MEMORY_SCOPE_AGENT); }
                    dead = true; break; }
                __builtin_amdgcn_s_sleep(2);
            }
            __builtin_amdgcn_fence(__ATOMIC_ACQUIRE, "agent");
            if (lane == 0) flag[0] = dead ? 1u : 0u;
        }
        asm volatile("s_waitcnt vmcnt(0) lgkmcnt(0)" ::: "memory"); __builtin_amdgcn_s_barrier(); asm volatile("" ::: "memory");
        const bool bad = flag[0] != 0u;
        if (lane < 32) {
            const unsigned long long* slot = (const unsigned long long*)xbuf + (size_t)(u.pm * BM + row) * 4; float mt[4], m2[4]; float ms = 0.f;
#pragma unroll
            for (int t = 0; t < 4; ++t) { if (t < ntn) { const unsigned long long w = __hip_atomic_load(slot + t, __ATOMIC_RELAXED, __HIP_MEMORY_SCOPE_AGENT); mt[t] = __uint_as_float((unsigned)w); m2[t] = __uint_as_float((unsigned)(w >> 32)); } else { mt[t] = 0.f; m2[t] = 0.f; } ms += mt[t]; }
            const float mean = ms / (float)ntn; float q = 0.f;
#pragma unroll
            for (int t = 0; t < 4; ++t) if (t < ntn) { const float dm = mt[t] - mean; q += m2[t] + 256.0f * dm * dm; }
            S[row] = (f32x2v){mean, 1.0f / sqrtf(q / (256.0f * (float)ntn) + eps)};
        }
        asm volatile("s_waitcnt lgkmcnt(0)" ::: "memory"); __builtin_amdgcn_s_barrier(); asm volatile("" ::: "memory");
        return bad;
    }
};
struct EpiLnRes {
    static constexpr bool PERM = false, AFTER_DRAIN = true;
    const float* base; float* out; int ldc; const float* bias; PanelStats st; unsigned poison;
    __device__ __forceinline__ void fused(f32x4 (&acc)[2][2][4][2], const Unit& u, int wr, int wc, int fr, int fq, PG8_LAS unsigned char* lds, int wid, int lane) const {
        typedef float f32x2v __attribute__((ext_vector_type(2)));
        const PG8_LAS f32x2v* S = (const PG8_LAS f32x2v*)(lds + 8192);
        const int col0 = u.pn * BM + wc * 32 + 4 * fq;
#pragma unroll
        for (int bj = 0; bj < 2; ++bj)
#pragma unroll
            for (int n = 0; n < 2; ++n) { const f32x4 bv = bias ? *(const f32x4*)(bias + col0 + bj * HALF + n * 16) : (f32x4){0.f, 0.f, 0.f, 0.f};
#pragma unroll
                for (int ai = 0; ai < 2; ++ai)
#pragma unroll
                    for (int m = 0; m < 4; ++m) acc[ai][bj][m][n] += bv; }
        f32x4 pre[4][2][2];
#pragma unroll
        for (int m = 0; m < 4; ++m) { const size_t off = (size_t)(u.pm * BM + wr * 64 + m * 16 + fr) * ldc + col0;
#pragma unroll
            for (int bj = 0; bj < 2; ++bj)
#pragma unroll
                for (int n = 0; n < 2; ++n) pre[m][bj][n] = *(const f32x4*)(base + off + bj * HALF + n * 16); }
        const bool bad = st.run(acc, u, wr, wc, fr, fq, lds, wid, lane) || poison != 0u;
        const float qnan = __builtin_nanf("");
#pragma unroll
        for (int ai = 0; ai < 2; ++ai)
#pragma unroll
            for (int m = 0; m < 4; ++m) { const int r = ai * HALF + wr * 64 + m * 16 + fr; const f32x2v sr = S[r]; const size_t off = (size_t)(u.pm * BM + r) * ldc + col0;
#pragma unroll
                for (int bj = 0; bj < 2; ++bj)
#pragma unroll
                    for (int n = 0; n < 2; ++n) { const f32x4 bs = ai == 0 ? pre[m][bj][n] : *(const f32x4*)(base + off + bj * HALF + n * 16); f32x4 o = bs + (acc[ai][bj][m][n] - sr.x) * sr.y;
                        if (bad) o = (f32x4){qnan, qnan, qnan, qnan}; *(f32x4*)(out + off + bj * HALF + n * 16) = o; }
                if (m & 1) asm volatile("" ::: "memory"); }
    }
};
struct EpiLnResLn {
    static constexpr bool PERM = false, AFTER_DRAIN = true;
    const float* base; float* out; bf16_t* xn; int ldc; const float* bias; PanelStats st1, st2; unsigned poison;
    __device__ __forceinline__ void fused(f32x4 (&acc)[2][2][4][2], const Unit& u, int wr, int wc, int fr, int fq, PG8_LAS unsigned char* lds, int wid, int lane) const {
        typedef float f32x2v __attribute__((ext_vector_type(2))); typedef unsigned u32x2v __attribute__((ext_vector_type(2)));
        const PG8_LAS f32x2v* S = (const PG8_LAS f32x2v*)(lds + 8192);
        const int col0 = u.pn * BM + wc * 32 + 4 * fq;
#pragma unroll
        for (int bj = 0; bj < 2; ++bj)
#pragma unroll
            for (int n = 0; n < 2; ++n) { const f32x4 bv = bias ? *(const f32x4*)(bias + col0 + bj * HALF + n * 16) : (f32x4){0.f, 0.f, 0.f, 0.f};
#pragma unroll
                for (int ai = 0; ai < 2; ++ai)
#pragma unroll
                    for (int m = 0; m < 4; ++m) acc[ai][bj][m][n] += bv; }
        bool bad = st1.run(acc, u, wr, wc, fr, fq, lds, wid, lane) || poison != 0u;
        const float qnan = __builtin_nanf("");
#pragma unroll
        for (int ai = 0; ai < 2; ++ai)
#pragma unroll
            for (int m = 0; m < 4; ++m) { const int r = ai * HALF + wr * 64 + m * 16 + fr; const f32x2v sr = S[r]; const size_t off = (size_t)(u.pm * BM + r) * ldc + col0;
#pragma unroll
                for (int bj = 0; bj < 2; ++bj)
#pragma unroll
                    for (int n = 0; n < 2; ++n) { const f32x4 bs = *(const f32x4*)(base + off + bj * HALF + n * 16); acc[ai][bj][m][n] = bs + (acc[ai][bj][m][n] - sr.x) * sr.y; }
                asm volatile("" : "+v"(acc[ai][0][m][0]), "+v"(acc[ai][0][m][1]), "+v"(acc[ai][1][m][0]), "+v"(acc[ai][1][m][1]));
                if (m & 1) asm volatile("" ::: "memory"); }
        const bool bad1 = bad;
        bad = st2.run(acc, u, wr, wc, fr, fq, lds, wid, lane) || bad;
#pragma unroll
        for (int ai = 0; ai < 2; ++ai)
#pragma unroll
            for (int m = 0; m < 4; ++m) { const int r = ai * HALF + wr * 64 + m * 16 + fr; const f32x2v sr = S[r]; const size_t off = (size_t)(u.pm * BM + r) * ldc + col0;
#pragma unroll
                for (int bj = 0; bj < 2; ++bj)
#pragma unroll
                    for (int n = 0; n < 2; ++n) { const f32x4 x1 = acc[ai][bj][m][n]; *(f32x4*)(out + off + bj * HALF + n * 16) = bad1 ? (f32x4){qnan, qnan, qnan, qnan} : x1;
                        const f32x4 o = (x1 - sr.x) * sr.y; u32x2v w; w.x = cvt_pk_bf16(o[0], o[1]); w.y = cvt_pk_bf16(o[2], o[3]);
                        if (bad) { w.x = 0x7fc07fc0u; w.y = 0x7fc07fc0u; } *(u32x2v*)(xn + off + bj * HALF + n * 16) = w; }
                asm volatile("" ::: "memory"); }
    }
};

template <class Epi, class Sched, bool ALIGN_EPI = false, bool SP2 = false>
__device__ __forceinline__ void gemm_phase(PG8_LAS unsigned char* lds, const Gemm g, const Sched& S, const Epi& E) {
    const int tid = threadIdx.x, wid = __builtin_amdgcn_readfirstlane(tid >> 6), lane = tid & 63, wr = wid >> 2, wc = wid & 3, fr = lane & 15, fq = lane >> 4;
    const int K = g.K, nt = K / BK;
    unsigned voffA[2], voffB[2];
#pragma unroll
    for (int i = 0; i < 2; ++i) { int R, C; stage_rc(tid * 16 + i * 8192, R, C); const int Rb = Epi::PERM ? ((R & ~31) + perm32(R & 31)) : R;
        voffA[i] = (unsigned)(R * K + C) * 2u; voffB[i] = (unsigned)(Rb * K + C) * 2u; }
    const size_t kstep = (size_t)(BK * 2);
    const size_t hstep = (size_t)HALF * K * 2;
    const size_t tstep = 2 * hstep;
    const unsigned ldsw = (unsigned)wid * 1024u;
    const int aoff = lds_byte(wr * 64 + fr, fq * 8), boff = lds_byte(wc * 32 + fr, fq * 8);
#define PG8_SA(b, h) (((b) * 2 + (h)) * HTB)
#define PG8_SB(b, h) ((4 + (b) * 2 + (h)) * HTB)
#define PG8_STAGE(bufoff, gbase, voff) do { _Pragma("unroll") for (int _i = 0; _i < 2; ++_i) \
        __builtin_amdgcn_global_load_lds((const unsigned*)((const char*)(gbase) + (voff)[_i]), (PG8_LAS unsigned*)(lds + (bufoff) + ldsw + _i * 8192), 16, 0, 0); } while (0)
#define PG8_LDA(dst, b, h) do { _Pragma("unroll") for (int m = 0; m < 4; ++m) _Pragma("unroll") for (int k = 0; k < 2; ++k) dst[m][k] = *(const PG8_LAS bf16x8*)(lds + PG8_SA(b, h) + aoff + m * 2048 + k * 1024); } while (0)
#define PG8_LDB(dst, b, h) do { _Pragma("unroll") for (int n = 0; n < 2; ++n) _Pragma("unroll") for (int k = 0; k < 2; ++k) dst[n][k] = *(const PG8_LAS bf16x8*)(lds + PG8_SB(b, h) + boff + n * 2048 + k * 1024); } while (0)
#define PG8_MMA(ai, bj, At, Bt) do { __builtin_amdgcn_s_setprio(1); _Pragma("unroll") for (int m = 0; m < 4; ++m) _Pragma("unroll") for (int n = 0; n < 2; ++n) _Pragma("unroll") for (int k = 0; k < 2; ++k) \
        acc[ai][bj][m][n] = __builtin_amdgcn_mfma_f32_16x16x32_bf16(Bt[n][k], At[m][k], acc[ai][bj][m][n], 0, 0, 0); __builtin_amdgcn_s_setprio(0); } while (0)
#define PG8_WAIT_V(n) asm volatile("s_waitcnt vmcnt(" #n ")" ::: "memory")
#define PG8_WAIT_L(n) asm volatile("s_waitcnt lgkmcnt(" #n ")" ::: "memory")
#define PG8_BAR __builtin_amdgcn_s_barrier()
#define PG8_SCHED __builtin_amdgcn_sched_barrier(0)
    Unit cur, nxt; int ui = 0;
    if (!S.next(0, cur)) return;
    f32x4 acc[2][2][4][2];
#pragma unroll
    for (int a = 0; a < 2; ++a)
#pragma unroll
        for (int b = 0; b < 2; ++b)
#pragma unroll
            for (int m = 0; m < 4; ++m)
#pragma unroll
                for (int n = 0; n < 2; ++n) acc[a][b][m][n] = (f32x4){0.f, 0.f, 0.f, 0.f};
    bf16x8 At[4][2], B0[2][2], B1[2][2];
    const char* cA = (const char*)g.A + (size_t)cur.pm * tstep; const char* cB = (const char*)g.Bt + (size_t)cur.pn * tstep;
    S.a_ready(cur);
    if constexpr (SP2) {
        PG8_STAGE(PG8_SB(0, 0), cB, voffB); PG8_STAGE(PG8_SB(0, 1), cB + hstep, voffB); PG8_STAGE(PG8_SA(0, 0), cA, voffA); PG8_STAGE(PG8_SA(0, 1), cA + hstep, voffA);
        if (wr == 1) PG8_BAR;
        PG8_WAIT_V(2); PG8_BAR;
        PG8_STAGE(PG8_SB(1, 0), cB + kstep, voffB); PG8_STAGE(PG8_SA(1, 0), cA + kstep, voffA); PG8_STAGE(PG8_SB(1, 1), cB + hstep + kstep, voffB);
        PG8_WAIT_V(6); PG8_BAR;
    } else {
        PG8_STAGE(PG8_SB(0, 0), cB, voffB); PG8_STAGE(PG8_SA(0, 0), cA, voffA); PG8_STAGE(PG8_SB(0, 1), cB + hstep, voffB); PG8_STAGE(PG8_SA(0, 1), cA + hstep, voffA);
        if (wr == 1) PG8_BAR;
        PG8_WAIT_V(4); PG8_BAR;
        PG8_STAGE(PG8_SB(1, 0), cB + kstep, voffB); PG8_STAGE(PG8_SA(1, 0), cA + kstep, voffA); PG8_STAGE(PG8_SB(1, 1), cB + hstep + kstep, voffB);
        PG8_WAIT_V(6); PG8_BAR;
    }
    for (;;) {
        const bool has_next = S.next(ui + 1, nxt);
        const char* nA = has_next ? (const char*)g.A + (size_t)nxt.pm * tstep : cA; const char* nB = has_next ? (const char*)g.Bt + (size_t)nxt.pn * tstep : cB;
        for (int t = 0; t < nt; t += 2) {
            const bool last = (t == nt - 2);
            const char* a1 = cA + (size_t)(t + 1) * kstep;
            const char* a2 = last ? nA : cA + (size_t)(t + 2) * kstep; const char* b2 = last ? nB : cB + (size_t)(t + 2) * kstep;
            const char* a3 = a2 + kstep; const char* b3 = b2 + kstep;
            if (last && has_next) S.a_ready(nxt);
            if constexpr (SP2) {
            PG8_LDB(B0, 0, 0); PG8_LDB(B1, 0, 1); PG8_SCHED; PG8_LDA(At, 0, 0); PG8_STAGE(PG8_SA(1, 1), a1 + hstep, voffA);
            PG8_WAIT_V(8); PG8_WAIT_L(0); PG8_BAR; PG8_MMA(0, 0, At, B0); PG8_MMA(0, 1, At, B1); PG8_BAR; PG8_SCHED;
            PG8_LDA(At, 0, 1); PG8_STAGE(PG8_SB(0, 0), b2, voffB); PG8_STAGE(PG8_SB(0, 1), b2 + hstep, voffB); PG8_STAGE(PG8_SA(0, 0), a2, voffA);
            PG8_WAIT_V(8); PG8_WAIT_L(0); PG8_BAR; PG8_MMA(1, 0, At, B0); PG8_MMA(1, 1, At, B1); PG8_BAR; PG8_SCHED;
            PG8_LDB(B0, 1, 0); PG8_LDB(B1, 1, 1); PG8_SCHED; PG8_LDA(At, 1, 0); PG8_STAGE(PG8_SA(0, 1), a2 + hstep, voffA);
            PG8_WAIT_V(8); PG8_WAIT_L(0); PG8_BAR; PG8_MMA(0, 0, At, B0); PG8_MMA(0, 1, At, B1); PG8_BAR; PG8_SCHED;
            PG8_LDA(At, 1, 1); PG8_STAGE(PG8_SB(1, 0), b3, voffB); PG8_STAGE(PG8_SB(1, 1), b3 + hstep, voffB); PG8_STAGE(PG8_SA(1, 0), a3, voffA);
            PG8_WAIT_V(8); PG8_WAIT_L(0); PG8_BAR; PG8_MMA(1, 0, At, B0); PG8_MMA(1, 1, At, B1); PG8_BAR; PG8_SCHED;
            } else {
            PG8_LDB(B0, 0, 0); PG8_SCHED; PG8_LDA(At, 0, 0); PG8_STAGE(PG8_SA(1, 1), a1 + hstep, voffA);
            PG8_WAIT_L(8); PG8_BAR; PG8_WAIT_L(0); PG8_MMA(0, 0, At, B0); PG8_BAR; PG8_SCHED;
            PG8_LDB(B1, 0, 1); PG8_STAGE(PG8_SB(0, 0), b2, voffB);
            PG8_BAR; PG8_WAIT_L(0); PG8_MMA(0, 1, At, B1); PG8_BAR;
            PG8_LDA(At, 0, 1); PG8_STAGE(PG8_SA(0, 0), a2, voffA);
            PG8_BAR; PG8_WAIT_L(0); PG8_MMA(1, 0, At, B0); PG8_BAR; PG8_SCHED;
            PG8_STAGE(PG8_SB(0, 1), b2 + hstep, voffB);
            PG8_WAIT_V(6); PG8_BAR; PG8_MMA(1, 1, At, B1); PG8_BAR;
            PG8_LDB(B0, 1, 0); PG8_SCHED; PG8_LDA(At, 1, 0); PG8_STAGE(PG8_SA(0, 1), a2 + hstep, voffA);
            PG8_WAIT_L(8); PG8_BAR; PG8_WAIT_L(0); PG8_MMA(0, 0, At, B0); PG8_BAR; PG8_SCHED;
            PG8_LDB(B1, 1, 1); PG8_STAGE(PG8_SB(1, 0), b3, voffB);
            PG8_BAR; PG8_WAIT_L(0); PG8_MMA(0, 1, At, B1); PG8_BAR;
            PG8_LDA(At, 1, 1); PG8_STAGE(PG8_SA(1, 0), a3, voffA);
            PG8_BAR; PG8_WAIT_L(0); PG8_MMA(1, 0, At, B0); PG8_BAR; PG8_SCHED;
            PG8_STAGE(PG8_SB(1, 1), b3 + hstep, voffB);
            PG8_WAIT_V(6); PG8_BAR; PG8_MMA(1, 1, At, B1); PG8_BAR;
            }
        }
        if constexpr (ALIGN_EPI) { if (wr == 0) PG8_BAR; }
        if constexpr (!Epi::AFTER_DRAIN) { E(acc, cur, wr, wc, fr, fq); S.done(cur); }
        if (!has_next) break;
#pragma unroll
        for (int a = 0; a < 2; ++a)
#pragma unroll
            for (int b = 0; b < 2; ++b)
#pragma unroll
                for (int m = 0; m < 4; ++m)
#pragma unroll
                    for (int n = 0; n < 2; ++n) acc[a][b][m][n] = (f32x4){0.f, 0.f, 0.f, 0.f};
        cur = nxt; cA = nA; cB = nB; ++ui;
        if constexpr (ALIGN_EPI) { if (wr == 1) PG8_BAR; }
    }
    PG8_WAIT_V(0);
    if constexpr (!ALIGN_EPI) { if (wr == 0) PG8_BAR; }
    PG8_BAR;
    if constexpr (Epi::AFTER_DRAIN) { E.fused(acc, cur, wr, wc, fr, fq, lds, wid, lane); S.done(cur); }
#undef PG8_SA
#undef PG8_SB
#undef PG8_STAGE
#undef PG8_LDA
#undef PG8_LDB
#undef PG8_MMA
#undef PG8_WAIT_V
#undef PG8_WAIT_L
#undef PG8_BAR
#undef PG8_SCHED
}
}
constexpr int D = 1024, SEQ = 8192, BATCH = 2, MROWS = BATCH * SEQ, DFF = 4096, NINP = 4608;
constexpr int NCMP = 511;
constexpr float ALPHA = 1.189207115002721f;
constexpr float LN_EPS = 1e-5f;
constexpr int LDS_BYTES = 147456;
constexpr int NT = 512;
constexpr size_t MiB = 1u << 20;
constexpr size_t WS_WIN = 1 * MiB, WS_WPGM = 15 * MiB, WS_WPNSA = 17 * MiB, WS_WOUT = 19 * MiB, WS_WFF1 = 21 * MiB, WS_WFF2 = 29 * MiB;
constexpr size_t WS_W1K = 37 * MiB, WS_W1V = 38 * MiB, WS_KC = 39 * MiB, WS_VC = 39 * MiB + 512 * 1024, WS_STATS = 40 * MiB, WS_G = 41 * MiB;
constexpr size_t WS_XB = 42 * MiB, WS_U = 74 * MiB, WS_V = 106 * MiB, WS_Q = 138 * MiB, WS_KV = 170 * MiB;
constexpr size_t WS_T = WS_Q, WS_S = WS_KV, WS_MERGED = WS_V, WS_HB = WS_XB, WS_A = 74 * MiB, WS_YN = 218 * MiB;
typedef unsigned short bf16;
typedef unsigned u32x4 __attribute__((ext_vector_type(4)));
typedef float f32x4 __attribute__((ext_vector_type(4)));

struct Params {
  const float* x; const float* w_in; const float* gm_ln_g; const float* gm_ln_b; const float* gm_w_s; const float* gm_b_s;
  const float* pe_k; const float* w1_k; const float* w2_k; const float* pe_v; const float* w1_v; const float* w2_v;
  const float* w_pgm; const float* w_pnsa; const float* w_out; const float* ln1_g; const float* ln1_b;
  const float* w_ff1; const float* w_ff2; const float* ln2_g; const float* ln2_b;
  float* out; unsigned char* ws; int ph_lo, ph_hi;
};

__device__ __forceinline__ int tid_l() { int t = threadIdx.x; asm volatile("" : "+v"(t)); return t; }
__device__ __forceinline__ int bid_l() { int t = blockIdx.x; asm volatile("" : "+s"(t)); return t; }
__device__ __forceinline__ float wave_sum(float v) {
#pragma unroll
  for (int o = 1; o < 64; o <<= 1) v += __shfl_xor(v, o);
  return v;
}
__device__ __forceinline__ float wave_max(float v) {
#pragma unroll
  for (int o = 1; o < 64; o <<= 1) v = fmaxf(v, __shfl_xor(v, o));
  return v;
}
__device__ __forceinline__ float gelu_tanh(float x) {
  const float c = 0.7978845608028654f;
  return 0.5f * x * (1.0f + tanhf(c * (x + 0.044715f * x * x * x)));
}
__device__ __forceinline__ float sigmoidf_(float x) { return 1.0f / (1.0f + expf(-x)); }
__device__ __forceinline__ unsigned f2bf(float f) { unsigned u = __builtin_bit_cast(unsigned, f); return (u + 0x7fffu + ((u >> 16) & 1u)) >> 16; }
__device__ __forceinline__ unsigned pk2(float lo, float hi) { return f2bf(lo) | (f2bf(hi) << 16); }
__device__ __forceinline__ float bf2f(bf16 v) { return __builtin_bit_cast(float, (unsigned)v << 16); }
__device__ __forceinline__ float bflo(unsigned w) { return __builtin_bit_cast(float, w << 16); }
__device__ __forceinline__ float bfhi(unsigned w) { return __builtin_bit_cast(float, w & 0xffff0000u); }

namespace pg8 {
__device__ __forceinline__ f32x2 gelu_tanh_pk(f32x2 v) {
  const f32x2 u = v * ((v * v) * 0.044715f + 1.0f);
  const f32x2 s = u * (-2.0f * 0.7978845608028654f * 1.4426950408889634f);
  f32x2 e; e.x = __builtin_amdgcn_exp2f(s.x); e.y = __builtin_amdgcn_exp2f(s.y);
  const f32x2 d = e + 1.0f; f32x2 r; r.x = __builtin_amdgcn_rcpf(d.x); r.y = __builtin_amdgcn_rcpf(d.y);
  return v * r;
}
__device__ __forceinline__ f32x2 sigmoid_pk(f32x2 v) {
  const f32x2 s = v * (-1.4426950408889634f);
  f32x2 e; e.x = __builtin_amdgcn_exp2f(s.x); e.y = __builtin_amdgcn_exp2f(s.y);
  const f32x2 d = e + 1.0f; f32x2 r; r.x = __builtin_amdgcn_rcpf(d.x); r.y = __builtin_amdgcn_rcpf(d.y);
  return r;
}
template <int ACT> __device__ __forceinline__ void act8(f32x4& v0, f32x4& v1) {
  if (ACT == 1) { f32x2 a = gelu_tanh_pk((f32x2){v0[0], v0[1]}), b = gelu_tanh_pk((f32x2){v0[2], v0[3]}), c = gelu_tanh_pk((f32x2){v1[0], v1[1]}), d = gelu_tanh_pk((f32x2){v1[2], v1[3]});
    v0 = (f32x4){a.x, a.y, b.x, b.y}; v1 = (f32x4){c.x, c.y, d.x, d.y}; }
  if (ACT == 2) { v0 = v0 * 0.08838834764831845f; v1 = v1 * 0.08838834764831845f; }
  if (ACT == 3) { f32x2 a = sigmoid_pk((f32x2){v0[0], v0[1]}), b = sigmoid_pk((f32x2){v0[2], v0[3]}), c = sigmoid_pk((f32x2){v1[0], v1[1]}), d = sigmoid_pk((f32x2){v1[2], v1[3]});
    v0 = (f32x4){a.x, a.y, b.x, b.y}; v1 = (f32x4){c.x, c.y, d.x, d.y}; }
  if (ACT == 4) { const f32x4 z = {0.f, 0.f, 0.f, 0.f}; v0 = __builtin_elementwise_max(v0, z); v1 = __builtin_elementwise_max(v1, z); v0 = v0 * v0; v1 = v1 * v1; }
}
__device__ __forceinline__ u32x4 pack8(const f32x4 v0, const f32x4 v1) { u32x4 w; w.x = cvt_pk_bf16(v0[0], v0[1]); w.y = cvt_pk_bf16(v0[2], v0[3]); w.z = cvt_pk_bf16(v1[0], v1[1]); w.w = cvt_pk_bf16(v1[2], v1[3]); return w; }
__device__ __forceinline__ void unpack8(const u32x4 w, f32x4& v0, f32x4& v1) { v0 = (f32x4){bflo(w.x), bfhi(w.x), bflo(w.y), bfhi(w.y)}; v1 = (f32x4){bflo(w.z), bfhi(w.z), bflo(w.w), bfhi(w.w)}; }

template <int ACT> __device__ __forceinline__ void store_tile_bf16(const f32x4 (&acc)[2][2][4][2], bf16_t* base, int ldc, int row0, int cl0, int ncl) {
#pragma unroll
  for (int ai = 0; ai < 2; ++ai)
#pragma unroll
    for (int m = 0; m < 4; ++m) { bf16_t* rowp = base + (size_t)(row0 + ai * HALF + m * 16) * ldc + cl0;
#pragma unroll
      for (int bj = 0; bj < 2; ++bj) { f32x4 v0 = acc[ai][bj][m][0], v1 = acc[ai][bj][m][1]; act8<ACT>(v0, v1);
        if (cl0 + bj * HALF < ncl) *(u32x4*)(rowp + bj * HALF) = pack8(v0, v1); } }
}
struct EpiIn {
  static constexpr bool PERM = true, AFTER_DRAIN = false;
  bf16_t *U, *V, *Q, *KV;
  __device__ __forceinline__ void operator()(const f32x4 (&acc)[2][2][4][2], const Unit& u, int wr, int wc, int fr, int fq) const {
    const int pn = u.pn, row0 = u.pm * BM + wr * 64 + fr, cl0 = wc * 32 + 8 * fq;
    if (pn < 4) store_tile_bf16<1>(acc, U + pn * 256, 1024, row0, cl0, 256);
    else if (pn < 8) store_tile_bf16<1>(acc, V + (pn - 4) * 256, 1024, row0, cl0, 256);
    else if (pn < 12) store_tile_bf16<2>(acc, Q + (pn - 8) * 256, 1024, row0, cl0, 256);
    else store_tile_bf16<0>(acc, KV + (size_t)(pn - 12) * MROWS * 256, 256, row0, cl0, 256);
  }
};
template <int MODE> struct EpiMix {
  static constexpr bool PERM = true, AFTER_DRAIN = false;
  bf16_t* O; int ldc; const bf16_t* T; const bf16_t* S;
  __device__ __forceinline__ void operator()(const f32x4 (&acc)[2][2][4][2], const Unit& u, int wr, int wc, int fr, int fq) const {
    const int row0 = u.pm * BM + wr * 64 + fr, col0 = u.pn * BM + wc * 32 + 8 * fq;
#pragma unroll
    for (int ai = 0; ai < 2; ++ai)
#pragma unroll
      for (int m = 0; m < 4; ++m) { const size_t row = (size_t)(row0 + ai * HALF + m * 16);
#pragma unroll
        for (int bj = 0; bj < 2; ++bj) { f32x4 v0 = acc[ai][bj][m][0], v1 = acc[ai][bj][m][1]; const size_t off = row * ldc + col0 + bj * HALF;
          if (MODE == 0) act8<4>(v0, v1);
          if (MODE == 3) act8<3>(v0, v1);
          if (MODE == 5) { f32x4 s0, s1; unpack8(*(const u32x4*)(S + off), s0, s1); v0 = v0 * s0; v1 = v1 * s1; }
          if (MODE == 4) { f32x4 t0, t1; unpack8(*(const u32x4*)(T + off), t0, t1); v0 = v0 * t0; v1 = v1 * t1; }
          if (MODE == 5) { f32x4 t0, t1; unpack8(*(const u32x4*)(T + off), t0, t1); v0 = v0 + t0; v1 = v1 + t1; }
          *(u32x4*)(O + off) = pack8(v0, v1); } }
  }
};
struct EpiRes {
  static constexpr bool PERM = true, AFTER_DRAIN = false;
  float* O; const float* R;
  __device__ __forceinline__ void operator()(const f32x4 (&acc)[2][2][4][2], const Unit& u, int wr, int wc, int fr, int fq) const {
    const int row0 = u.pm * BM + wr * 64 + fr, col0 = u.pn * BM + wc * 32 + 8 * fq;
#pragma unroll
    for (int ai = 0; ai < 2; ++ai)
#pragma unroll
      for (int m = 0; m < 4; ++m) { const size_t row = (size_t)(row0 + ai * HALF + m * 16);
#pragma unroll
        for (int bj = 0; bj < 2; ++bj) { const size_t off = row * 1024 + col0 + bj * HALF;
          const f32x4 r0 = *(const f32x4*)(R + off), r1 = *(const f32x4*)(R + off + 4);
          *(f32x4*)(O + off) = r0 * ALPHA + acc[ai][bj][m][0]; *(f32x4*)(O + off + 4) = r1 * ALPHA + acc[ai][bj][m][1]; } }
  }
};
}

#define LAS __attribute__((address_space(3)))
#define GAS __attribute__((address_space(1)))
#define LDS_WAIT() asm volatile("s_waitcnt lgkmcnt(0)" ::: "memory")

__device__ __forceinline__ void p0_transpose_item(const float* W, int ldw, int src_col0, int nvalid, int ncols, int K, bf16* WT, int dst_row0, LAS float* scr, int item, int lane) {
  const int nblk = ncols / 32, kb = item / nblk, nb = item % nblk, k0 = 64 * kb, n0 = 32 * nb;
  const int nn = n0 + (lane & 31);
#pragma unroll 8
  for (int i = 0; i < 32; ++i) { const int kk = 2 * i + (lane >> 5); scr[kk * 33 + (lane & 31)] = (nn < nvalid) ? W[(size_t)(k0 + kk) * ldw + src_col0 + nn] : 0.f; }
  LDS_WAIT(); asm volatile("" ::: "memory");
  const int c = lane & 7;
#pragma unroll
  for (int j = 0; j < 4; ++j) { const int n = (lane >> 3) + 8 * j; const LAS float* s = scr + (8 * c) * 33 + n;
    u32x4 o; o.x = pk2(s[0 * 33], s[1 * 33]); o.y = pk2(s[2 * 33], s[3 * 33]); o.z = pk2(s[4 * 33], s[5 * 33]); o.w = pk2(s[6 * 33], s[7 * 33]);
    *(u32x4*)(WT + (size_t)(dst_row0 + n0 + n) * K + k0 + 8 * c) = o; }
  LDS_WAIT(); asm volatile("" ::: "memory");
}
__device__ __forceinline__ void p0_prologue(const Params& p, unsigned char* lds_raw) {
  const int tid = tid_l(), bid = bid_l(), lane = tid & 63, wave = tid >> 6;
  LAS float* scr = (LAS float*)((LAS unsigned char*)lds_raw + wave * 16384);
  const int gw = bid * 8 + wave, NGW = gridDim.x * 8;
  unsigned char* ws = p.ws;
  constexpr int I_A = 16 * (4608 / 32), I_M = 16 * (2048 / 32), I_G = 16 * (256 / 32), I_P = 16 * (1024 / 32), I_1 = 16 * (4096 / 32), I_2 = 64 * (1024 / 32);
  constexpr int NITEMS = I_A + I_M + I_G + 3 * I_P + I_1 + I_2;
  for (int it = gw; it < NITEMS; it += NGW) {
    int r = it;
    if (r < I_A) { p0_transpose_item(p.w_in, 6680, 0, 4608, 4608, 1024, (bf16*)(ws + WS_WIN), 0, scr, r, lane); continue; } r -= I_A;
    if (r < I_M) { p0_transpose_item(p.w_in, 6680, 4632, 2048, 2048, 1024, (bf16*)(ws + WS_WIN), 4608, scr, r, lane); continue; } r -= I_M;
    if (r < I_G) { p0_transpose_item(p.w_in, 6680, 4608, 24, 256, 1024, (bf16*)(ws + WS_WIN), 6656, scr, r, lane); continue; } r -= I_G;
    if (r < I_P) { p0_transpose_item(p.w_pgm, 1024, 0, 1024, 1024, 1024, (bf16*)(ws + WS_WPGM), 0, scr, r, lane); continue; } r -= I_P;
    if (r < I_P) { p0_transpose_item(p.w_pnsa, 1024, 0, 1024, 1024, 1024, (bf16*)(ws + WS_WPNSA), 0, scr, r, lane); continue; } r -= I_P;
    if (r < I_P) { p0_transpose_item(p.w_out, 1024, 0, 1024, 1024, 1024, (bf16*)(ws + WS_WOUT), 0, scr, r, lane); continue; } r -= I_P;
    if (r < I_1) { p0_transpose_item(p.w_ff1, 4096, 0, 4096, 4096, 1024, (bf16*)(ws + WS_WFF1), 0, scr, r, lane); continue; } r -= I_1;
    p0_transpose_item(p.w_ff2, 1024, 0, 1024, 1024, 4096, (bf16*)(ws + WS_WFF2), 0, scr, r, lane);
  }
  { float* WG = (float*)(ws + WS_W1K); for (int i = bid * NT + tid; i < 1024 * 24; i += gridDim.x * NT) WG[i] = p.w_in[(size_t)(i / 24) * 6680 + 4608 + (i % 24)]; }
  bf16* XB = (bf16*)(ws + WS_XB);
  const size_t n8 = (size_t)MROWS * D / 8;
  for (size_t i = (size_t)bid * NT + tid; i < n8; i += (size_t)gridDim.x * NT) {
    const f32x4 a = *(const f32x4*)(p.x + i * 8), b = *(const f32x4*)(p.x + i * 8 + 4);
    u32x4 o; o.x = pk2(a[0], a[1]); o.y = pk2(a[2], a[3]); o.z = pk2(b[0], b[1]); o.w = pk2(b[2], b[3]);
    *(u32x4*)(XB + i * 8) = o;
  }
}

__device__ __forceinline__ void vstats_phase(const bf16* V, float* stats) {
  const int tid = tid_l(), lane = tid & 63, gw = bid_l() * (NT / 64) + (tid >> 6), ngw = gridDim.x * (NT / 64);
  for (int r = gw; r < MROWS; r += ngw) {
    const bf16* v = V + (size_t)r * 1024;
    float vv[16]; float s = 0.f;
#pragma unroll
    for (int h = 0; h < 2; ++h) { const u32x4 w = *(const u32x4*)(v + h * 512 + lane * 8);
      vv[h * 8 + 0] = bflo(w.x); vv[h * 8 + 1] = bfhi(w.x); vv[h * 8 + 2] = bflo(w.y); vv[h * 8 + 3] = bfhi(w.y); vv[h * 8 + 4] = bflo(w.z); vv[h * 8 + 5] = bfhi(w.z); vv[h * 8 + 6] = bflo(w.w); vv[h * 8 + 7] = bfhi(w.w); }
#pragma unroll
    for (int i = 0; i < 16; ++i) s += vv[i];
    const float mu = wave_sum(s) * (1.f / 1024.f);
    float q = 0.f;
#pragma unroll
    for (int i = 0; i < 16; ++i) { const float d = vv[i] - mu; q += d * d; }
    const float var = wave_sum(q) * (1.f / 1024.f);
    if (lane == 0) { stats[2 * r] = mu; stats[2 * r + 1] = 1.0f / sqrtf(var + LN_EPS); }
  }
}
__device__ __forceinline__ void ln_rows_phase(float* X, const float* g, const float* b, bf16* XBo) {
  const int tid = tid_l(), lane = tid & 63, gw = bid_l() * (NT / 64) + (tid >> 6), ngw = gridDim.x * (NT / 64);
  for (int r = gw; r < MROWS; r += ngw) {
    float* x = X + (size_t)r * D;
    f32x4 vv[4]; float s = 0.f;
#pragma unroll
    for (int i = 0; i < 4; ++i) { vv[i] = *(const f32x4*)(x + i * 256 + lane * 4); s += (vv[i][0] + vv[i][1]) + (vv[i][2] + vv[i][3]); }
    const float mu = wave_sum(s) * (1.f / 1024.f);
    float q = 0.f;
#pragma unroll
    for (int i = 0; i < 4; ++i) { const f32x4 d = vv[i] - mu; q += (d[0] * d[0] + d[1] * d[1]) + (d[2] * d[2] + d[3] * d[3]); }
    const float rstd = 1.0f / sqrtf(wave_sum(q) * (1.f / 1024.f) + LN_EPS);
#pragma unroll
    for (int i = 0; i < 4; ++i) { const int c = i * 256 + lane * 4; const f32x4 gg = *(const f32x4*)(g + c), bb = *(const f32x4*)(b + c);
      const f32x4 o = (vv[i] - mu) * rstd * gg + bb; *(f32x4*)(x + c) = o;
      if (XBo) { uint2 w; w.x = pk2(o[0], o[1]); w.y = pk2(o[2], o[3]); *(uint2*)(XBo + (size_t)r * D + c) = w; } }
  }
}
__device__ __forceinline__ void gmlp_naive_phase(float* lds, bf16* U, const bf16* V, const float* stats, const Params& p) {
  const int tid = tid_l(), bid = bid_l();
  float* lv = lds;
  const int nitems = (MROWS / 128) * 8;
  for (int it = bid; it < nitems; it += gridDim.x) {
    const int n = it >> 3, g = it & 7;
    const int r0 = n * 128, c0 = g * 128;
    for (int e = tid; e < 128 * 128; e += NT) {
      const int j = e >> 7, d = e & 127;
      const float v = bf2f(V[(size_t)(r0 + j) * 1024 + c0 + d]);
      lv[e] = (v - stats[2 * (r0 + j)]) * stats[2 * (r0 + j) + 1] * p.gm_ln_g[c0 + d] + p.gm_ln_b[c0 + d];
    }
    __syncthreads();
    const int i = tid >> 2, dq = (tid & 3) * 32;
    float acc[32];
#pragma unroll
    for (int e = 0; e < 32; ++e) acc[e] = 0.f;
    const float* wrow = p.gm_w_s + ((size_t)g * 128 + i) * 128;
    for (int j = 0; j <= i; ++j) {
      const float w = wrow[j];
#pragma unroll
      for (int e = 0; e < 32; ++e) acc[e] = fmaf(w, lv[j * 128 + dq + e], acc[e]);
    }
    const float bs = p.gm_b_s[g * 128 + i];
    bf16* urow = U + (size_t)(r0 + i) * 1024 + c0 + dq;
#pragma unroll
    for (int e = 0; e < 32; ++e) urow[e] = (bf16)f2bf(bf2f(urow[e]) * (acc[e] + bs));
    __syncthreads();
  }
}
__device__ __forceinline__ void compress_naive_phase(float* lds, const bf16* KCin, const bf16* VCin, bf16* KC, bf16* VC, const Params& p) {
  const int tid = tid_l(), bid = bid_l(), sub = tid >> 7, t = tid & 127;
  float* flat = lds + sub * (4096 + 128);
  float* hid = flat + 4096;
  const int nitems = BATCH * NCMP * 2 * 2;
  const int nrounds = (nitems + 3) / 4;
  for (int rd = bid; rd < nrounds; rd += gridDim.x) {
    const int it = rd * 4 + sub;
    const bool ok = it < nitems;
    const int which = ok ? it / (BATCH * NCMP * 2) : 0, rem = ok ? it % (BATCH * NCMP * 2) : 0, b = rem / (NCMP * 2), r2 = rem % (NCMP * 2), i = r2 >> 1, h = r2 & 1;
    const float* pe = which ? p.pe_v : p.pe_k; const float* w1 = which ? p.w1_v : p.w1_k; const float* w2 = which ? p.w2_v : p.w2_k;
    const bf16* src = which ? VCin : KCin;
    for (int e = t; e < 4096; e += 128) { const int pp = e >> 7, d = e & 127; flat[e] = bf2f(src[(size_t)(b * SEQ + 16 * i + pp) * 256 + h * 128 + d]) + pe[pp * 128 + d]; }
    __syncthreads();
    float a = 0.f;
    for (int k = 0; k < 4096; ++k) a = fmaf(flat[k], w1[(size_t)k * 128 + t], a);
    hid[t] = gelu_tanh(a);
    __syncthreads();
    float o = 0.f;
    for (int k = 0; k < 128; ++k) o = fmaf(hid[k], w2[k * 128 + t], o);
    if (ok) (which ? VC : KC)[((size_t)(b * NCMP + i) * 2 + h) * 128 + t] = (bf16)f2bf(o);
    __syncthreads();
  }
}

namespace att {
typedef short bf16x8 __attribute__((ext_vector_type(8)));
typedef short s16x4 __attribute__((ext_vector_type(4)));
typedef float f32x16 __attribute__((ext_vector_type(16)));
#define ATT_MFMA(a, b, c) __builtin_amdgcn_mfma_f32_32x32x16_bf16((a), (b), (c), 0, 0, 0)
constexpr int KROW = 272, VROW = 72;
constexpr int KBUF = 32 * KROW, VBUF = 128 * VROW, TBUF = KBUF + VBUF;
constexpr int OFF_IMP = 2 * TBUF, OFF_SEL = OFF_IMP + 64 * 128 * 4, OFF_WU = OFF_SEL + 64 * 4 * 4, OFF_UL = OFF_WU + 256, OFF_Y = OFF_UL + 768, YROW = 272;
static_assert(OFF_Y + 256 * YROW <= 147456 - 64, "attention LDS map");
constexpr float LOG2E = 1.4426950408889634f;
__device__ __forceinline__ int crow(int i, int h) { return (i & 3) + 8 * (i >> 2) + 4 * h; }
__device__ __forceinline__ unsigned pkbf(float lo, float hi) {
  typedef __bf16 v2bf __attribute__((ext_vector_type(2))); typedef float v2f __attribute__((ext_vector_type(2)));
  const v2f f = {lo, hi}; const v2bf b = __builtin_convertvector(f, v2bf); return __builtin_bit_cast(unsigned, b);
}
__device__ __forceinline__ f32x16 qk_tile(const char* kb, const char* qb, int r, int h) {
  f32x16 x;
#pragma unroll
  for (int i = 0; i < 16; ++i) x[i] = 0.f;
#pragma unroll
  for (int ks = 0; ks < 8; ++ks) { const bf16x8 a = *(const bf16x8*)(kb + r * KROW + ks * 32 + h * 16); const bf16x8 bq = *(const bf16x8*)(qb + ks * 32); x = ATT_MFMA(a, bq, x); if (ks == 3) asm volatile("" ::: "memory"); }
  return x;
}
__device__ __forceinline__ void pv_tile(const char* vb, const f32x16& p, const float sc_, f32x16 (&o)[4], int r, int h) {
  u32x4 w0, w1;
  w0.x = pkbf(p[0] * sc_, p[1] * sc_); w0.y = pkbf(p[2] * sc_, p[3] * sc_); w0.z = pkbf(p[4] * sc_, p[5] * sc_); w0.w = pkbf(p[6] * sc_, p[7] * sc_);
  w1.x = pkbf(p[8] * sc_, p[9] * sc_); w1.y = pkbf(p[10] * sc_, p[11] * sc_); w1.z = pkbf(p[12] * sc_, p[13] * sc_); w1.w = pkbf(p[14] * sc_, p[15] * sc_);
  const bf16x8 ps0 = __builtin_bit_cast(bf16x8, w0), ps1 = __builtin_bit_cast(bf16x8, w1);
#pragma unroll
  for (int dt = 0; dt < 4; ++dt) {
    const char* vr = vb + (32 * dt + r) * VROW + 8 * h;
    const s16x4 a0 = *(const s16x4*)(vr), a1 = *(const s16x4*)(vr + 16), a2 = *(const s16x4*)(vr + 32), a3 = *(const s16x4*)(vr + 48);
    o[dt] = ATT_MFMA(__builtin_shufflevector(a0, a1, 0, 1, 2, 3, 4, 5, 6, 7), ps0, o[dt]);
    o[dt] = ATT_MFMA(__builtin_shufflevector(a2, a3, 0, 1, 2, 3, 4, 5, 6, 7), ps1, o[dt]);
    if (dt & 1) asm volatile("" ::: "memory");
  }
}
__device__ __forceinline__ void stage_store(char* buf, const u32x4 kreg, const u32x4 vreg, bool withv, int skk, int sc) {
  *(u32x4*)(buf + skk * KROW + sc * 16) = kreg;
  if (withv) {
    char* vb = buf + KBUF + (8 * sc) * VROW + skk * 2;
    *(unsigned short*)(vb + 0 * VROW) = (unsigned short)(vreg.x & 0xffffu); *(unsigned short*)(vb + 1 * VROW) = (unsigned short)(vreg.x >> 16);
    *(unsigned short*)(vb + 2 * VROW) = (unsigned short)(vreg.y & 0xffffu); *(unsigned short*)(vb + 3 * VROW) = (unsigned short)(vreg.y >> 16);
    *(unsigned short*)(vb + 4 * VROW) = (unsigned short)(vreg.z & 0xffffu); *(unsigned short*)(vb + 5 * VROW) = (unsigned short)(vreg.z >> 16);
    *(unsigned short*)(vb + 6 * VROW) = (unsigned short)(vreg.w & 0xffffu); *(unsigned short*)(vb + 7 * VROW) = (unsigned short)(vreg.w >> 16);
  }
}
#define ATT_TILE_LOOP(NTILES, ROW0, ROWMAX, KB, VB, WITHV, ...) do { const int nt_ = (NTILES); if (nt_ > 0) { u32x4 kreg_, vreg_ = {0u, 0u, 0u, 0u}; \
    { const int i_ = 0; const int row_ = max(min((ROW0) + skk, (ROWMAX)), 0); kreg_ = *(const u32x4*)((KB) + (size_t)row_ * 256 + sc * 8); if (WITHV) vreg_ = *(const u32x4*)((VB) + (size_t)row_ * 256 + sc * 8); } \
    stage_store(lds, kreg_, vreg_, WITHV, skk, sc); __syncthreads(); \
    for (int ti_ = 0; ti_ < nt_; ++ti_) { const char* buf_ = lds + (ti_ & 1) * TBUF; \
      if (ti_ + 1 < nt_) { const int i_ = ti_ + 1; const int row_ = max(min((ROW0) + skk, (ROWMAX)), 0); kreg_ = *(const u32x4*)((KB) + (size_t)row_ * 256 + sc * 8); if (WITHV) vreg_ = *(const u32x4*)((VB) + (size_t)row_ * 256 + sc * 8); } \
      { const int i_ = ti_; __VA_ARGS__ } \
      if (ti_ + 1 < nt_) stage_store(lds + ((ti_ + 1) & 1) * TBUF, kreg_, vreg_, WITHV, skk, sc); \
      __syncthreads(); } } } while (0)
#define ATT_PASS1_UPDATE(MC, LC) do { float tmax_ = -1e30f; _Pragma("unroll") for (int i = 0; i < 16; ++i) tmax_ = fmaxf(tmax_, sv[i]); \
    tmax_ = fmaxf(tmax_, __shfl_xor(tmax_, 32)); const float mn_ = fmaxf((MC), tmax_); float sum_ = 0.f; \
    _Pragma("unroll") for (int i = 0; i < 16; ++i) sum_ += (sv[i] > -1e29f) ? __builtin_amdgcn_exp2f(sv[i] - mn_) : 0.f; \
    sum_ += __shfl_xor(sum_, 32); (LC) = (LC) * __builtin_amdgcn_exp2f((MC) - mn_) + sum_; (MC) = mn_; } while (0)

__device__ __forceinline__ void attn_phase(char* lds, const bf16* Q, bf16* YN, const bf16* KVb, const float* X, const float* WG, const bf16* KC, const bf16* VC) {
  const int tid = tid_l(), bid = bid_l(), lane = tid & 63, w = __builtin_amdgcn_readfirstlane(tid >> 6), r = lane & 31, h = lane >> 5;
  const int R = 32 * w + r, qq = R >> 2, g = R & 3;
  const int skk = tid >> 4, sc = tid & 15;
  float* imp = (float*)(lds + OFF_IMP); unsigned* selm = (unsigned*)(lds + OFF_SEL); unsigned* wun = (unsigned*)(lds + OFF_WU); int* ulist = (int*)(lds + OFF_UL);
  for (int pass_u = 0; pass_u < 2; ++pass_u) {
    const int uidx = pass_u == 0 ? bid : 511 - bid;
    if (uidx < 0 || uidx >= 512 || (pass_u == 1 && uidx == bid)) continue;
    const int qb = uidx >> 2, b = (uidx >> 1) & 1, kv = uidx & 1;
    const int q0 = qb * 64, t = q0 + qq, head = kv * 4 + g;
    const int tw_lo = q0 + 8 * w, tw_hi = tw_lo + 7;
    const size_t rowg = (size_t)b * SEQ + t;
    char* const qrow_l = lds + OFF_Y + R * YROW + h * 16;
#pragma unroll
    for (int ks = 0; ks < 8; ++ks) *(bf16x8*)(qrow_l + ks * 32) = *(const bf16x8*)(Q + rowg * 1024 + head * 128 + ks * 16 + h * 8);
    float g0, g1, g2;
    { const float* xr = X + rowg * 1024 + h * 512; const float* wg = WG + (size_t)h * 512 * 24 + head * 3; float a0 = 0.f, a1 = 0.f, a2 = 0.f;
      for (int k = 0; k < 512; k += 4) { const f32x4 xv = *(const f32x4*)(xr + k);
#pragma unroll
        for (int e = 0; e < 4; ++e) { const float* wk = wg + (k + e) * 24; a0 = fmaf(xv[e], wk[0], a0); a1 = fmaf(xv[e], wk[1], a1); a2 = fmaf(xv[e], wk[2], a2); } }
      a0 += __shfl_xor(a0, 32); a1 += __shfl_xor(a1, 32); a2 += __shfl_xor(a2, 32);
      g0 = 1.0f / (1.0f + __expf(-a0)); g1 = 1.0f / (1.0f + __expf(-a1)); g2 = 1.0f / (1.0f + __expf(-a2)); }
    const float slope2 = exp2f(-(float)(head + 1)) * LOG2E;
    for (int i = tid; i < 64 * 128; i += NT) imp[i] = 0.f;
    f32x16 o[4];
#pragma unroll
    for (int dt = 0; dt < 4; ++dt)
#pragma unroll
      for (int i = 0; i < 16; ++i) o[dt][i] = 0.f;
    const bf16* KCb = KC + (size_t)b * NCMP * 256 + kv * 128; const bf16* VCb = VC + (size_t)b * NCMP * 256 + kv * 128;
    const bf16* KS = KVb + (size_t)2 * MROWS * 256 + (size_t)b * SEQ * 256 + kv * 128; const bf16* VS = KVb + (size_t)3 * MROWS * 256 + (size_t)b * SEQ * 256 + kv * 128;
    const bf16* KW = KVb + (size_t)4 * MROWS * 256 + (size_t)b * SEQ * 256 + kv * 128; const bf16* VW = KVb + (size_t)5 * MROWS * 256 + (size_t)b * SEQ * 256 + kv * 128;
    __syncthreads();
    float sv[16];
    const int ntc = (q0 + 63 >= 31) ? min((q0 + 32) / 512 + 1, 16) : 0;
    float mc = -1e30f, lc = 0.f;
    ATT_TILE_LOOP(ntc, 32 * i_, NCMP - 1, KCb, VCb, false, {
      if (512 * i_ + 31 <= tw_hi) {
        const f32x16 x = qk_tile(buf_, qrow_l, r, h);
        _Pragma("unroll")
        for (int i = 0; i < 16; ++i) { const int n = 32 * i_ + crow(i, h); const bool valid = 16 * n + 31 <= t; sv[i] = valid ? x[i] * LOG2E - slope2 * ((float)(t - 16 * n) - 15.5f) : -1e30f; }
        ATT_PASS1_UPDATE(mc, lc);
      } });
    { const float inv = lc > 0.f ? 1.0f / lc : 0.f;
    ATT_TILE_LOOP(ntc, 32 * i_, NCMP - 1, KCb, VCb, true, {
      if (512 * i_ + 31 <= tw_hi) {
        f32x16 pcs = qk_tile(buf_, qrow_l, r, h);
        _Pragma("unroll")
        for (int i = 0; i < 16; ++i) { const int n = 32 * i_ + crow(i, h); const bool valid = 16 * n + 31 <= t;
          pcs[i] = valid ? __builtin_amdgcn_exp2f(pcs[i] * LOG2E - slope2 * ((float)(t - 16 * n) - 15.5f) - mc) * inv : 0.f; }
        pv_tile(buf_ + KBUF, pcs, g0, o, r, h);
        _Pragma("unroll")
        for (int i = 0; i < 16; ++i) { pcs[i] += __shfl_xor(pcs[i], 1); pcs[i] += __shfl_xor(pcs[i], 2); }
        const float S0 = (pcs[0] + pcs[1]) + (pcs[2] + pcs[3]), S1 = (pcs[4] + pcs[5]) + (pcs[6] + pcs[7]), S2 = (pcs[8] + pcs[9]) + (pcs[10] + pcs[11]), S3 = (pcs[12] + pcs[13]) + (pcs[14] + pcs[15]);
        const float v0 = __shfl_xor(pcs[3], 32), v1 = __shfl_xor(pcs[7], 32), v2 = __shfl_xor(pcs[11], 32), v3 = __shfl_xor(pcs[15], 32);
        if (g == 0) { float* ir = imp + qq * 128 + 8 * i_;
          if (h == 0) { ir[0] += S0; ir[2] += S1 + v0; ir[4] += S2 + v1; ir[6] += S3 + v2; if (8 * i_ + 8 < 128) ir[8] += v3; }
          else { ir[1] += S0 + v0; ir[3] += S1 + v1; ir[5] += S2 + v2; ir[7] += S3 + v3; } }
      } }); }
    unsigned long long wu0 = 0ull, wu1 = 0ull;
    for (int ql = 0; ql < 8; ++ql) {
      const int qi = 8 * w + ql, cur = (q0 + qi) >> 6;
      float v0, v1;
      { const int m = lane, lag = cur - m; v0 = ((m == 0) || (lag >= 0 && lag < 2)) ? 1e9f : (lag >= 0 ? imp[qi * 128 + m] : -1.0f); }
      { const int m = lane + 64, lag = cur - m; v1 = (lag >= 0 && lag < 2) ? 1e9f : (lag >= 0 ? imp[qi * 128 + m] : -1.0f); }
      bool c0 = false, c1 = false;
      for (int rd = 0; rd < 16; ++rd) {
        float best; int bi;
        if (v0 >= v1) { best = v0; bi = lane; } else { best = v1; bi = lane + 64; }
#pragma unroll
        for (int of = 1; of < 64; of <<= 1) { const float ov = __shfl_xor(best, of); const int oi = __shfl_xor(bi, of); if (ov > best || (ov == best && oi < bi)) { best = ov; bi = oi; } }
        if (bi == lane) { c0 = true; v0 = -3e38f; }
        if (bi == lane + 64) { c1 = true; v1 = -3e38f; }
      }
      const unsigned long long b0 = __ballot(c0), b1 = __ballot(c1);
      if (lane == 0) { selm[qi * 4 + 0] = (unsigned)b0; selm[qi * 4 + 1] = (unsigned)(b0 >> 32); selm[qi * 4 + 2] = (unsigned)b1; selm[qi * 4 + 3] = (unsigned)(b1 >> 32); }
      wu0 |= b0; wu1 |= b1;
    }
    if (lane == 0) { wun[w * 4 + 0] = (unsigned)wu0; wun[w * 4 + 1] = (unsigned)(wu0 >> 32); wun[w * 4 + 2] = (unsigned)wu1; wun[w * 4 + 3] = (unsigned)(wu1 >> 32); }
    __syncthreads();
    const unsigned mk0 = selm[qq * 4 + 0], mk1 = selm[qq * 4 + 1], mk2 = selm[qq * 4 + 2], mk3 = selm[qq * 4 + 3];
    if (w == 0) {
      unsigned u0 = 0, u1 = 0, u2 = 0, u3 = 0;
#pragma unroll
      for (int ww = 0; ww < 8; ++ww) { u0 |= wun[ww * 4 + 0]; u1 |= wun[ww * 4 + 1]; u2 |= wun[ww * 4 + 2]; u3 |= wun[ww * 4 + 3]; }
      const unsigned long long U0 = ((unsigned long long)u1 << 32) | u0, U1 = ((unsigned long long)u3 << 32) | u2;
      const bool in0 = ((U0 >> lane) & 1ull) && (lane <= qb), in1 = ((U1 >> lane) & 1ull) && (lane + 64 <= qb);
      const unsigned long long B0 = __ballot(in0), B1 = __ballot(in1);
      const unsigned long long below = (lane == 0) ? 0ull : (~0ull >> (64 - lane));
      if (in0) ulist[__popcll(B0 & below)] = lane;
      if (in1) ulist[__popcll(B0) + __popcll(B1 & below)] = lane + 64;
      if (lane == 0) ulist[160] = __popcll(B0) + __popcll(B1);
    }
    __syncthreads();
    const int nU = ulist[160];
    float ms = -1e30f, ls = 0.f;
    ATT_TILE_LOOP(2 * nU, ulist[i_ >> 1] * 64 + (i_ & 1) * 32, SEQ - 1, KS, VS, false, {
      const int m = ulist[i_ >> 1], pos0 = m * 64 + (i_ & 1) * 32;
      const bool wsel = ((m < 64 ? (wu0 >> m) : (wu1 >> (m - 64))) & 1ull) != 0ull;
      if (wsel && pos0 <= tw_hi) {
        const f32x16 x = qk_tile(buf_, qrow_l, r, h);
        const unsigned wm = m < 32 ? mk0 : m < 64 ? mk1 : m < 96 ? mk2 : mk3; const bool rsel = ((wm >> (m & 31)) & 1u) != 0u;
        _Pragma("unroll")
        for (int i = 0; i < 16; ++i) { const int pos = pos0 + crow(i, h); const bool valid = rsel && pos <= t; sv[i] = valid ? x[i] * LOG2E - slope2 * (float)(t - pos) : -1e30f; }
        ATT_PASS1_UPDATE(ms, ls);
      } });
    { const float inv = ls > 0.f ? g1 / ls : 0.f;
    ATT_TILE_LOOP(2 * nU, ulist[i_ >> 1] * 64 + (i_ & 1) * 32, SEQ - 1, KS, VS, true, {
      const int m = ulist[i_ >> 1], pos0 = m * 64 + (i_ & 1) * 32;
      const bool wsel = ((m < 64 ? (wu0 >> m) : (wu1 >> (m - 64))) & 1ull) != 0ull;
      if (wsel && pos0 <= tw_hi) {
        f32x16 x = qk_tile(buf_, qrow_l, r, h);
        const unsigned wm = m < 32 ? mk0 : m < 64 ? mk1 : m < 96 ? mk2 : mk3; const bool rsel = ((wm >> (m & 31)) & 1u) != 0u;
        _Pragma("unroll")
        for (int i = 0; i < 16; ++i) { const int pos = pos0 + crow(i, h); const bool valid = rsel && pos <= t;
          x[i] = valid ? __builtin_amdgcn_exp2f(x[i] * LOG2E - slope2 * (float)(t - pos) - ms) : 0.f; }
        pv_tile(buf_ + KBUF, x, inv, o, r, h);
      } }); }
    const int wp0 = max(q0 - 512, 0), ntw = (q0 + 64 - wp0) / 32;
    float mw = -1e30f, lw = 0.f;
    ATT_TILE_LOOP(ntw, wp0 + 32 * i_, SEQ - 1, KW, VW, false, {
      const int pos0 = wp0 + 32 * i_;
      if (pos0 <= tw_hi && pos0 + 31 >= tw_lo - 511) {
        const f32x16 x = qk_tile(buf_, qrow_l, r, h);
        _Pragma("unroll")
        for (int i = 0; i < 16; ++i) { const int d = t - (pos0 + crow(i, h)); const bool valid = d >= 0 && d < 512; sv[i] = valid ? x[i] * LOG2E - slope2 * (float)d : -1e30f; }
        ATT_PASS1_UPDATE(mw, lw);
      } });
    { const float inv = lw > 0.f ? g2 / lw : 0.f;
    ATT_TILE_LOOP(ntw, wp0 + 32 * i_, SEQ - 1, KW, VW, true, {
      const int pos0 = wp0 + 32 * i_;
      if (pos0 <= tw_hi && pos0 + 31 >= tw_lo - 511) {
        f32x16 x = qk_tile(buf_, qrow_l, r, h);
        _Pragma("unroll")
        for (int i = 0; i < 16; ++i) { const int d = t - (pos0 + crow(i, h)); const bool valid = d >= 0 && d < 512;
          x[i] = valid ? __builtin_amdgcn_exp2f(x[i] * LOG2E - slope2 * (float)d - mw) : 0.f; }
        pv_tile(buf_ + KBUF, x, inv, o, r, h);
      } }); }
    { char* yb = lds + OFF_Y + R * YROW;
#pragma unroll
      for (int dt = 0; dt < 4; ++dt)
#pragma unroll
        for (int i = 0; i < 16; ++i) *(unsigned short*)(yb + (32 * dt + crow(i, h)) * 2) = (unsigned short)f2bf(o[dt][i]);
      __syncthreads();
      const int RR = tid >> 1, hf = tid & 1; const char* ys = lds + OFF_Y + RR * YROW + hf * 128;
      bf16* yd = YN + ((size_t)b * SEQ + q0 + (RR >> 2)) * 1024 + (kv * 4 + (RR & 3)) * 128 + hf * 64;
#pragma unroll
      for (int c = 0; c < 8; ++c) *(u32x4*)(yd + c * 8) = *(const u32x4*)(ys + c * 16);
      __syncthreads(); }
  }
}
}


#ifndef PROBE_LEVEL
#define PROBE_LEVEL 0
#endif
#define PROBE_BUF(L, K, BUF) if (PROBE_LEVEL == (L)) { if (IN(K)) { const int tid = tid_l(), bid = bid_l(); \
      for (size_t e = (size_t)bid * NT + tid; e < (size_t)MROWS * 1024; e += (size_t)gridDim.x * NT) p.out[e] = bf2f((BUF)[e]); } \
    if (p.ph_lo >= (K)) return; }
#define RLX_AGENT __ATOMIC_RELAXED, __HIP_MEMORY_SCOPE_AGENT
#define XB_TMO      128
#define XB_XCNT(j)  (256  + 64 * (j))
#define XB_XSUB(j)  (1280 + 64 * (j))
#define XB_XGEN(j)  (2304 + 64 * (j))
#define XB_TOP      3328
#define XB_TOPGEN   3392
#define XCD_BAR_WORDS 3456
#define XB_SPIN_CAP (1u << 18)

__device__ __forceinline__ unsigned xb_ld(unsigned* p)              { return __hip_atomic_load(p, __ATOMIC_RELAXED, __HIP_MEMORY_SCOPE_AGENT); }
__device__ __forceinline__ unsigned xb_add(unsigned* p, unsigned v) { return __hip_atomic_fetch_add(p, v, __ATOMIC_RELAXED, __HIP_MEMORY_SCOPE_AGENT); }
__device__ __forceinline__ unsigned xb_xcc_id() { return (unsigned)__builtin_amdgcn_s_getreg((3 << 11) | 20) & 0xFu; }
#define XB_SPIN(cond, bar) do { unsigned _sp = 0; while (cond) { __builtin_amdgcn_s_sleep(1); \
    if ((++_sp & 255u) == 0u) { if (xb_ld(&(bar)[XB_TMO])) break; if (_sp > XB_SPIN_CAP) { atomicAdd(&(bar)[XB_TMO], 1u); break; } } } } while (0)

struct XcdBarrier {
    unsigned* bar; unsigned x;
    volatile LAS unsigned* st;
};

__device__ __forceinline__ XcdBarrier xcd_barrier_post(unsigned* bar, volatile LAS unsigned* st) {
    XcdBarrier b; b.bar = bar; b.x = xb_xcc_id(); b.st = st;
    if (threadIdx.x == 0) (void)xb_add(&bar[XB_XCNT(b.x)], 1u);
    return b;
}
__device__ __forceinline__ void xcd_barrier_complete(unsigned* bar, unsigned x, unsigned& nloc, unsigned& nx) {
    const unsigned G = gridDim.x * gridDim.y * gridDim.z;
    unsigned sum, cnt, mine, sp = 0u;
    for (;;) {
        sum = 0u; cnt = 0u; mine = 0u;
#pragma unroll
        for (unsigned j = 0; j < 16; ++j) { const unsigned c = xb_ld(&bar[XB_XCNT(j)]); sum += c; cnt += (c > 0u) ? 1u : 0u; mine = (j == x) ? c : mine; }
        if (sum == G) break;
        __builtin_amdgcn_s_sleep(1);
        if ((++sp & 255u) == 0u) { if (xb_ld(&bar[XB_TMO])) break; if (sp > XB_SPIN_CAP) { atomicAdd(&bar[XB_TMO], 1u); break; } }
    }
    nloc = mine > 0u ? mine : 1u; nx = cnt > 0u ? cnt : 1u;
}

__device__ __forceinline__ void xcd_barrier(const XcdBarrier& b) {
    asm volatile("s_waitcnt vmcnt(0)" ::: "memory");
    __syncthreads();
    if (threadIdx.x == 0) {
        unsigned* bar = b.bar;
        __builtin_amdgcn_s_waitcnt(0);
        unsigned nloc = b.st[0], nx = b.st[1];
        if (nloc == 0u) { xcd_barrier_complete(bar, b.x, nloc, nx); b.st[0] = nloc; b.st[1] = nx; }
        const unsigned old = xb_add(&bar[XB_XSUB(b.x)], 1u);
        const unsigned gen = old / nloc;
        if (old + 1u == (gen + 1u) * nloc) {
            __builtin_amdgcn_fence(__ATOMIC_RELEASE, "agent");
            asm volatile("s_waitcnt vmcnt(0)" ::: "memory");
            const unsigned og = xb_add(&bar[XB_TOP], 1u);
            const unsigned tg = og / nx;
            if (og + 1u == (tg + 1u) * nx) xb_add(&bar[XB_TOPGEN], 1u);
            else XB_SPIN(xb_ld(&bar[XB_TOPGEN]) == tg, bar);
            __builtin_amdgcn_fence(__ATOMIC_ACQUIRE, "agent");
            xb_add(&bar[XB_XGEN(b.x)], 1u);
            asm volatile("s_waitcnt vmcnt(0)" ::: "memory");
        } else {
            XB_SPIN(xb_ld(&bar[XB_XGEN(b.x)]) == gen, bar);
            __builtin_amdgcn_fence(__ATOMIC_ACQUIRE, "agent");
            asm volatile("s_waitcnt vmcnt(0)" ::: "memory");
        }
    }
    __syncthreads();
}


__global__ void __launch_bounds__(NT, 2) fwd_megakernel(Params p) {
  extern __shared__ __attribute__((aligned(16))) unsigned char lds_raw[];
  float* ldsf = (float*)lds_raw;
  PG8_LAS unsigned char* ldsl = (PG8_LAS unsigned char*)lds_raw;
  cg::grid_group grid = cg::this_grid();
  volatile LAS unsigned* MISC = (volatile LAS unsigned*)((LAS unsigned char*)lds_raw + 147456 - 64);
  if (threadIdx.x < 16) MISC[threadIdx.x] = 0u;
  __syncthreads();
  const bool multi = (p.ph_hi - p.ph_lo) > 1;
  XcdBarrier bar; bar.bar = (unsigned*)p.ws; bar.x = 0; bar.st = MISC;
  if (multi) { grid.sync(); bar = xcd_barrier_post((unsigned*)p.ws, MISC); }
#define IN(k) (p.ph_lo <= (k) && (k) < p.ph_hi)
#define SEAM(k) do { if (IN(k) && IN((k) + 1)) xcd_barrier(bar); } while (0)
  unsigned char* ws = p.ws;
  bf16* W_IN = (bf16*)(ws + WS_WIN); bf16* W_PGM = (bf16*)(ws + WS_WPGM); bf16* W_PNSA = (bf16*)(ws + WS_WPNSA); bf16* W_OUT = (bf16*)(ws + WS_WOUT);
  bf16* W_FF1 = (bf16*)(ws + WS_WFF1); bf16* W_FF2 = (bf16*)(ws + WS_WFF2);
  bf16* KC = (bf16*)(ws + WS_KC); bf16* VC = (bf16*)(ws + WS_VC); float* stats = (float*)(ws + WS_STATS);
  bf16* XB = (bf16*)(ws + WS_XB); bf16* U = (bf16*)(ws + WS_U); bf16* V = (bf16*)(ws + WS_V); bf16* Q = (bf16*)(ws + WS_Q); bf16* KVb = (bf16*)(ws + WS_KV);
  bf16* TB = (bf16*)(ws + WS_T); bf16* SB = (bf16*)(ws + WS_S); bf16* MERGED = (bf16*)(ws + WS_MERGED); bf16* HB = (bf16*)(ws + WS_HB); bf16* A = (bf16*)(ws + WS_A);
  bf16* YN = (bf16*)(ws + WS_YN);
  const int bx = blockIdx.x;
  if (IN(0)) p0_prologue(p, lds_raw);
  SEAM(0);
  if (IN(1)) { pg8::Gemm g{XB, W_IN, MROWS, NINP, D}; pg8::StaticOrder S; S.init(MROWS, NINP, gridDim.x, bx);
    pg8::EpiIn E{U, V, Q, KVb};
    pg8::gemm_phase<pg8::EpiIn, pg8::StaticOrder, true, true>(ldsl, g, S, E); }
  SEAM(1);
  if (IN(2)) { vstats_phase(V, stats); compress_naive_phase(ldsf, KVb, KVb + (size_t)MROWS * 256, KC, VC, p); }
  SEAM(2);
  if (IN(3)) { gmlp_naive_phase(ldsf, U, V, stats, p); att::attn_phase((char*)lds_raw, Q, YN, KVb, p.x, (const float*)(ws + WS_W1K), KC, VC); }
  SEAM(3);
  if (IN(4)) {
    { pg8::Gemm g{XB, W_IN + (size_t)4608 * 1024, MROWS, D, D}; pg8::StaticOrder S; S.init(MROWS, D, gridDim.x, bx);
      pg8::EpiMix<3> E{TB, 1024, nullptr, nullptr};
      pg8::gemm_phase<pg8::EpiMix<3>, pg8::StaticOrder, false, true>(ldsl, g, S, E); }
    asm volatile("s_waitcnt vmcnt(0)" ::: "memory"); __syncthreads();
    { pg8::Gemm g{U, W_PGM, MROWS, D, D}; pg8::StaticOrder S; S.init(MROWS, D, gridDim.x, bx);
      pg8::EpiMix<4> E{TB, 1024, TB, nullptr};
      pg8::gemm_phase<pg8::EpiMix<4>, pg8::StaticOrder, false, true>(ldsl, g, S, E); }
    asm volatile("s_waitcnt vmcnt(0)" ::: "memory"); __syncthreads();
    { pg8::Gemm g{XB, W_IN + (size_t)5632 * 1024, MROWS, D, D}; pg8::StaticOrder S; S.init(MROWS, D, gridDim.x, bx);
      pg8::EpiMix<3> E{SB, 1024, nullptr, nullptr};
      pg8::gemm_phase<pg8::EpiMix<3>, pg8::StaticOrder, false, true>(ldsl, g, S, E); }
    asm volatile("s_waitcnt vmcnt(0)" ::: "memory"); __syncthreads();
    { pg8::Gemm g{YN, W_PNSA, MROWS, D, D}; pg8::StaticOrder S; S.init(MROWS, D, gridDim.x, bx);
      pg8::EpiMix<5> E{MERGED, 1024, TB, SB};
      pg8::gemm_phase<pg8::EpiMix<5>, pg8::StaticOrder, false, true>(ldsl, g, S, E); }
  }
  SEAM(4);
  SEAM(5);
  if (IN(6)) { pg8::Gemm g{MERGED, W_OUT, MROWS, D, D}; pg8::StaticOrder S; S.init(MROWS, D, gridDim.x, bx);
    pg8::EpiRes E{p.out, p.x};
    pg8::gemm_phase<pg8::EpiRes, pg8::StaticOrder, true, true>(ldsl, g, S, E); }
  SEAM(6);
  if (IN(7)) ln_rows_phase(p.out, p.ln1_g, p.ln1_b, HB);
  SEAM(7);
  if (IN(8)) { pg8::Gemm g{HB, W_FF1, MROWS, DFF, D}; pg8::StaticOrder S; S.init(MROWS, DFF, gridDim.x, bx);
    pg8::EpiMix<0> E{A, DFF, nullptr, nullptr};
    pg8::gemm_phase<pg8::EpiMix<0>, pg8::StaticOrder, true, true>(ldsl, g, S, E); }
  SEAM(8);
  if (IN(9)) { pg8::Gemm g{A, W_FF2, MROWS, D, DFF}; pg8::StaticOrder S; S.init(MROWS, D, gridDim.x, bx);
    pg8::EpiRes E{p.out, p.out};
    pg8::gemm_phase<pg8::EpiRes, pg8::StaticOrder, true, true>(ldsl, g, S, E); }
  SEAM(9);
  if (IN(10)) ln_rows_phase(p.out, p.ln2_g, p.ln2_b, nullptr);
}

extern "C" void kernel_launch(void* const* d_in, const int* in_sizes, int n_in,
                              void* d_out, int out_size, void* d_ws, size_t ws_size,
                              hipStream_t stream) {
  static int grid_blocks = 0;
  if (!grid_blocks) {
    int dev = 0, cus = 0, per_cu = 0;
    (void)hipGetDevice(&dev);
    (void)hipDeviceGetAttribute(&cus, hipDeviceAttributeMultiprocessorCount, dev);
    (void)hipFuncSetAttribute((const void*)fwd_megakernel, hipFuncAttributeMaxDynamicSharedMemorySize, LDS_BYTES);
    (void)hipOccupancyMaxActiveBlocksPerMultiprocessor(&per_cu, (const void*)fwd_megakernel, NT, LDS_BYTES);
    if (per_cu < 1) fprintf(stderr, "kernel_launch: occupancy query says %d blocks/CU\n", per_cu);
    grid_blocks = cus;
  }
  Params p{};
  const float* const* in = (const float* const*)d_in;
  p.x = in[0]; p.w_in = in[1]; p.gm_ln_g = in[2]; p.gm_ln_b = in[3]; p.gm_w_s = in[4]; p.gm_b_s = in[5];
  p.pe_k = in[6]; p.w1_k = in[7]; p.w2_k = in[8]; p.pe_v = in[9]; p.w1_v = in[10]; p.w2_v = in[11];
  p.w_pgm = in[12]; p.w_pnsa = in[13]; p.w_out = in[14]; p.ln1_g = in[15]; p.ln1_b = in[16];
  p.w_ff1 = in[17]; p.w_ff2 = in[18]; p.ln2_g = in[19]; p.ln2_b = in[20];
  p.out = (float*)d_out; p.ws = (unsigned char*)d_ws;
  (void)hipMemsetAsync(d_ws, 0, 65536, stream);
#ifndef N_LAUNCH_SPLIT
#define N_LAUNCH_SPLIT 0
#endif
  if (N_LAUNCH_SPLIT) {
    for (int k = 0; k < 11; ++k) { p.ph_lo = k; p.ph_hi = k + 1; hipLaunchKernelGGL(fwd_megakernel, dim3(grid_blocks), dim3(NT), LDS_BYTES, stream, p); }
    return;
  }
  p.ph_lo = 0; p.ph_hi = 11;
  void* args[] = {&p};
  hipError_t e = hipLaunchCooperativeKernel((const void*)fwd_megakernel, dim3(grid_blocks), dim3(NT), args, LDS_BYTES, stream);
  if (e != hipSuccess) fprintf(stderr, "cooperative launch failed: %s (grid %d)\n", hipGetErrorString(e), grid_blocks);
}
```

```cpp
#define N_LAUNCH_SPLIT 0
#include <hip/hip_runtime.h>
#include <hip/hip_cooperative_groups.h>
#include <cstdio>
#include <cstdint>
namespace cg = cooperative_groups;
namespace pg8 {
#define PG8_LAS __attribute__((address_space(3)))
typedef unsigned short bf16_t;
typedef short bf16x8 __attribute__((ext_vector_type(8)));
typedef float f32x4 __attribute__((ext_vector_type(4)));
typedef unsigned u32x4 __attribute__((ext_vector_type(4)));
constexpr int BM = 256, BK = 64, HALF = 128, HTB = HALF * BK * 2  , STAGE_BYTES = 8 * HTB, NXCD = 8, WGM = 8;

__host__ __device__ __forceinline__ int lds_byte(int r, int c) { const int st = (r >> 4) * 2 + (c >> 5), rr = r & 15, cc = c & 31, ob = rr * 64 + cc * 2; return st * 1024 + (ob ^ (((ob >> 9) & 1) << 5)); }
__host__ __device__ __forceinline__ void stage_rc(int b, int& R, int& C) { const int st = b / 1024, sb = b % 1024, swz = sb ^ (((sb >> 9) & 1) << 5); R = (st >> 1) * 16 + swz / 64; C = (st & 1) * 32 + (swz % 64) / 2; }
__host__ __device__ __forceinline__ int perm32(int rho) { const int n = rho >> 4, i = rho & 15; return 8 * (i >> 2) + 4 * n + (i & 3); }

struct Unit { int pm, pn; };
struct Gemm { const bf16_t* A; const bf16_t* Bt; int M, N, K; };

struct StaticOrder {
    int nM, nN, nwg, G, c;
    __host__ __device__ void init(int M, int N, int G_, int c_) { nM = M / BM; nN = N / BM; nwg = nM * nN; G = G_; c = c_; }
    __host__ __device__ bool next(int i, Unit& u) const {
        const long L = (long)i * G + c; if (L >= nwg) return false;
        int wgid = (int)L; { const int q = nwg / NXCD, r = nwg % NXCD, xcd = wgid % NXCD, off = wgid / NXCD; wgid = (xcd < r ? xcd * (q + 1) : r * (q + 1) + (xcd - r) * q) + off; }
        const int nig = WGM * nN, gid = wgid / nig, fm = gid * WGM, gsz = (nM - fm) < WGM ? (nM - fm) : WGM;
        u.pm = fm + ((wgid % nig) % gsz); u.pn = (wgid % nig) / gsz; return true;
    }
    __device__ __forceinline__ void a_ready(const Unit&) const {}
    __device__ __forceinline__ void done(const Unit&) const {}
};

__device__ __forceinline__ unsigned cvt_pk_bf16(float lo, float hi) { unsigned r; asm volatile("v_cvt_pk_bf16_f32 %0, %1, %2" : "=v"(r) : "v"(lo), "v"(hi)); return r; }
typedef float f32x2 __attribute__((ext_vector_type(2)));
__device__ __forceinline__ f32x2 gelu_pk(f32x2 v) {
    const f32x2 av = __builtin_elementwise_abs(v), d = av * 0.2316418882f + 1.0f;
    f32x2 t; t.x = __builtin_amdgcn_rcpf(d.x); t.y = __builtin_amdgcn_rcpf(d.y);
    f32x2 q = t * 0.5307027145f + (-0.7265760135f); q = q * t + 0.7107068705f; q = q * t + (-0.142248368f); q = q * t + 0.127414796f; q = q * t;
    const f32x2 s = (v * v) * (-0.72134752044f);
    f32x2 e; e.x = __builtin_amdgcn_exp2f(s.x); e.y = __builtin_amdgcn_exp2f(s.y);
    const f32x2 m = v * (q * e), r = v - m;
    f32x2 o; o.x = v.x < 0.f ? m.x : r.x; o.y = v.y < 0.f ? m.y : r.y; return o;
}

template <int ACT  > struct EpiBf16 {
    static constexpr bool PERM = true, AFTER_DRAIN = false; static_assert(ACT == 0 || ACT == 1, "EpiBf16: ACT is 0 (none) or 1 (gelu_pk)");
    bf16_t* O; int ldc; const float* bias; int split_cols; size_t split_stride; float scale0;
    __device__ __forceinline__ void operator()(const f32x4 (&acc)[2][2][4][2], const Unit& u, int wr, int wc, int fr, int fq) const {
        const int row0 = u.pm * BM + wr * 64 + fr; int colt = u.pn * BM; bf16_t* base = O;
        float sc = 1.f; if (split_cols) { const int t = colt / split_cols; base += (size_t)t * split_stride; colt -= t * split_cols; if (t == 0) sc = scale0; }
        const int col0 = colt + wc * 32 + 8 * fq, bcol0 = u.pn * BM + wc * 32 + 8 * fq;
        f32x4 bv[2][2];
#pragma unroll
        for (int bj = 0; bj < 2; ++bj)
#pragma unroll
            for (int n = 0; n < 2; ++n) bv[bj][n] = bias ? *(const f32x4*)(bias + bcol0 + bj * HALF + 4 * n) : (f32x4){0.f, 0.f, 0.f, 0.f};
#pragma unroll
        for (int ai = 0; ai < 2; ++ai)
#pragma unroll
            for (int m = 0; m < 4; ++m) { bf16_t* rowp = base + (size_t)(row0 + ai * HALF + m * 16) * ldc + col0;
#pragma unroll
                for (int bj = 0; bj < 2; ++bj) { f32x4 v0 = acc[ai][bj][m][0] + bv[bj][0], v1 = acc[ai][bj][m][1] + bv[bj][1];
                    if (ACT == 1) { f32x2 a = gelu_pk((f32x2){v0[0], v0[1]}), b = gelu_pk((f32x2){v0[2], v0[3]}), c = gelu_pk((f32x2){v1[0], v1[1]}), d = gelu_pk((f32x2){v1[2], v1[3]});
                        v0 = (f32x4){a.x, a.y, b.x, b.y}; v1 = (f32x4){c.x, c.y, d.x, d.y}; }
                    v0 = v0 * sc; v1 = v1 * sc; u32x4 w; w.x = cvt_pk_bf16(v0[0], v0[1]); w.y = cvt_pk_bf16(v0[2], v0[3]); w.z = cvt_pk_bf16(v1[0], v1[1]); w.w = cvt_pk_bf16(v1[2], v1[3]);
                    *(u32x4*)(rowp + bj * HALF) = w; } }
    }
};

struct PanelStats {
    unsigned* xbuf;
    unsigned* cnt;
    unsigned* tmo;
    int ntn; float eps;
    unsigned code;
    __device__ __forceinline__ bool run(const f32x4 (&v)[2][2][4][2], const Unit& u, int wr, int wc, int fr, int fq, PG8_LAS unsigned char* lds, int wid, int lane) const {
        typedef float f32x2v __attribute__((ext_vector_type(2)));
        PG8_LAS f32x2v* P = (PG8_LAS f32x2v*)lds;
        PG8_LAS f32x2v* S = (PG8_LAS f32x2v*)(lds + 8192);
        PG8_LAS unsigned* flag = (PG8_LAS unsigned*)(lds + 8192 + 2048);
#pragma unroll
        for (int ai = 0; ai < 2; ++ai)
#pragma unroll
            for (int m = 0; m < 4; ++m) {
                float s = 0.f;
#pragma unroll
                for (int bj = 0; bj < 2; ++bj)
#pragma unroll
                    for (int n = 0; n < 2; ++n) { const f32x4 x = v[ai][bj][m][n]; s += (x[0] + x[1]) + (x[2] + x[3]); }
                s += __shfl_xor(s, 16); s += __shfl_xor(s, 32);
                const float mw = s * (1.0f / 64.0f); float q = 0.f;
#pragma unroll
                for (int bj = 0; bj < 2; ++bj)
#pragma unroll
                    for (int n = 0; n < 2; ++n) { const f32x4 d = v[ai][bj][m][n] - mw; q += (d[0] * d[0] + d[1] * d[1]) + (d[2] * d[2] + d[3] * d[3]); }
                q += __shfl_xor(q, 16); q += __shfl_xor(q, 32);
                if (fq == 0) P[(ai * HALF + wr * 64 + m * 16 + fr) * 4 + wc] = (f32x2v){mw, q};
            }
        asm volatile("s_waitcnt lgkmcnt(0)" ::: "memory"); __builtin_amdgcn_s_barrier(); asm volatile("" ::: "memory");
#if defined(BROKEN_EXCHANGE_NO_WAIT)
#warning BROKEN CONTROL BUILD: the row-statistics exchange does not wait; results are wrong by design
        if (blockIdx.x >= 64) { const long long t0_ = clock64(); while (clock64() - t0_ < 60000) __builtin_amdgcn_s_sleep(8); }
#endif
        const int row = wid * 32 + (lane & 31);
        if (lane < 32) {
            const f32x2v a = P[row * 4 + 0], b = P[row * 4 + 1], c = P[row * 4 + 2], d = P[row * 4 + 3];
            const float mt = (a.x + b.x + c.x + d.x) * 0.25f;
            const float da = a.x - mt, db = b.x - mt, dc = c.x - mt, dd = d.x - mt;
            const float m2 = (a.y + b.y) + (c.y + d.y) + 64.0f * ((da * da + db * db) + (dc * dc + dd * dd));
            unsigned long long* slot = (unsigned long long*)xbuf + ((size_t)(u.pm * BM + row) * 4 + u.pn);
            __hip_atomic_store(slot, ((unsigned long long)__float_as_uint(m2) << 32) | __float_as_uint(mt), __ATOMIC_RELAXED, __HIP_MEMORY_SCOPE_AGENT);
        }
        asm volatile("s_waitcnt vmcnt(0)" ::: "memory");
        if (lane == 0) __hip_atomic_fetch_add(cnt + 64 * u.pm, 1u, __ATOMIC_RELAXED, __HIP_MEMORY_SCOPE_AGENT);
        if (wid == 0) {
            bool dead = false; const unsigned long long t0 = __builtin_amdgcn_s_memrealtime(); const unsigned want = 8u * (unsigned)ntn;
            for (;;) {
#if defined(BROKEN_EXCHANGE_NO_WAIT)
                break;
#endif
                if ((unsigned)__builtin_amdgcn_readfirstlane(__hip_atomic_load(cnt + 64 * u.pm, __ATOMIC_RELAXED, __HIP_MEMORY_SCOPE_AGENT)) >= want) break;
                if (__builtin_amdgcn_s_memrealtime() - t0 > 2000000ull) {
                    if (lane == 0) { unsigned expect = 0u; __hip_atomic_compare_exchange_strong(tmo + 1, &expect, code | (unsigned)(u.pm & 0xff), __ATOMIC_RELAXED, __ATOMIC_RELAXED, __HIP_MEMORY_SCOPE_AGENT);
                                     __hip_atomic_store(tmo, 1u, __ATOMIC_RELAXED, __HIP_MEMORY_SCOPE_AGENT); }
                    dead = true; break; }
                __builtin_amdgcn_s_sleep(2);
            }
            __builtin_amdgcn_fence(__ATOMIC_ACQUIRE, "agent");
            if (lane == 0) flag[0] = dead ? 1u : 0u;
        }
        asm volatile("s_waitcnt vmcnt(0) lgkmcnt(0)" ::: "memory"); __builtin_amdgcn_s_barrier(); asm volatile("" ::: "memory");
        const bool bad = flag[0] != 0u;
        if (lane < 32) {
            const unsigned long long* slot = (const unsigned long long*)xbuf + (size_t)(u.pm * BM + row) * 4; float mt[4], m2[4]; float ms = 0.f;
#pragma unroll
            for (int t = 0; t < 4; ++t) { if (t < ntn) { const unsigned long long w = __hip_atomic_load(slot + t, __ATOMIC_RELAXED, __HIP_MEMORY_SCOPE_AGENT); mt[t] = __uint_as_float((unsigned)w); m2[t] = __uint_as_float((unsigned)(w >> 32)); } else { mt[t] = 0.f; m2[t] = 0.f; } ms += mt[t]; }
            const float mean = ms / (float)ntn; float q = 0.f;
#pragma unroll
            for (int t = 0; t < 4; ++t) if (t < ntn) { const float dm = mt[t] - mean; q += m2[t] + 256.0f * dm * dm; }
            S[row] = (f32x2v){mean, 1.0f / sqrtf(q / (256.0f * (float)ntn) + eps)};
        }
        asm volatile("s_waitcnt lgkmcnt(0)" ::: "memory"); __builtin_amdgcn_s_barrier(); asm volatile("" ::: "memory");
        return bad;
    }
};
struct EpiLnRes {
    static constexpr bool PERM = false, AFTER_DRAIN = true;
    const float* base; float* out; int ldc; const float* bias; PanelStats st; unsigned poison;
    __device__ __forceinline__ void fused(f32x4 (&acc)[2][2][4][2], const Unit& u, int wr, int wc, int fr, int fq, PG8_LAS unsigned char* lds, int wid, int lane) const {
        typedef float f32x2v __attribute__((ext_vector_type(2)));
        const PG8_LAS f32x2v* S = (const PG8_LAS f32x2v*)(lds + 8192);
        const int col0 = u.pn * BM + wc * 32 + 4 * fq;
#pragma unroll
        for (int bj = 0; bj < 2; ++bj)
#pragma unroll
            for (int n = 0; n < 2; ++n) { const f32x4 bv = bias ? *(const f32x4*)(bias + col0 + bj * HALF + n * 16) : (f32x4){0.f, 0.f, 0.f, 0.f};
#pragma unroll
                for (int ai = 0; ai < 2; ++ai)
#pragma unroll
                    for (int m = 0; m < 4; ++m) acc[ai][bj][m][n] += bv; }
        f32x4 pre[4][2][2];
#pragma unroll
        for (int m = 0; m < 4; ++m) { const size_t off = (size_t)(u.pm * BM + wr * 64 + m * 16 + fr) * ldc + col0;
#pragma unroll
            for (int bj = 0; bj < 2; ++bj)
#pragma unroll
                for (int n = 0; n < 2; ++n) pre[m][bj][n] = *(const f32x4*)(base + off + bj * HALF + n * 16); }
        const bool bad = st.run(acc, u, wr, wc, fr, fq, lds, wid, lane) || poison != 0u;
        const float qnan = __builtin_nanf("");
#pragma unroll
        for (int ai = 0; ai < 2; ++ai)
#pragma unroll
            for (int m = 0; m < 4; ++m) { const int r = ai * HALF + wr * 64 + m * 16 + fr; const f32x2v sr = S[r]; const size_t off = (size_t)(u.pm * BM + r) * ldc + col0;
#pragma unroll
                for (int bj = 0; bj < 2; ++bj)
#pragma unroll
                    for (int n = 0; n < 2; ++n) { const f32x4 bs = ai == 0 ? pre[m][bj][n] : *(const f32x4*)(base + off + bj * HALF + n * 16); f32x4 o = bs + (acc[ai][bj][m][n] - sr.x) * sr.y;
                        if (bad) o = (f32x4){qnan, qnan, qnan, qnan}; *(f32x4*)(out + off + bj * HALF + n * 16) = o; }
                if (m & 1) asm volatile("" ::: "memory"); }
    }
};
struct EpiLnResLn {
    static constexpr bool PERM = false, AFTER_DRAIN = true;
    const float* base; float* out; bf16_t* xn; int ldc; const float* bias; PanelStats st1, st2; unsigned poison;
    __device__ __forceinline__ void fused(f32x4 (&acc)[2][2][4][2], const Unit& u, int wr, int wc, int fr, int fq, PG8_LAS unsigned char* lds, int wid, int lane) const {
        typedef float f32x2v __attribute__((ext_vector_type(2))); typedef unsigned u32x2v __attribute__((ext_vector_type(2)));
        const PG8_LAS f32x2v* S = (const PG8_LAS f32x2v*)(lds + 8192);
        const int col0 = u.pn * BM + wc * 32 + 4 * fq;
#pragma unroll
        for (int bj = 0; bj < 2; ++bj)
#pragma unroll
            for (int n = 0; n < 2; ++n) { const f32x4 bv = bias ? *(const f32x4*)(bias + col0 + bj * HALF + n * 16) : (f32x4){0.f, 0.f, 0.f, 0.f};
#pragma unroll
                for (int ai = 0; ai < 2; ++ai)
#pragma unroll
                    for (int m = 0; m < 4; ++m) acc[ai][bj][m][n] += bv; }
        bool bad = st1.run(acc, u, wr, wc, fr, fq, lds, wid, lane) || poison != 0u;
        const float qnan = __builtin_nanf("");
#pragma unroll
        for (int ai = 0; ai < 2; ++ai)
#pragma unroll
            for (int m = 0; m < 4; ++m) { const int r = ai * HALF + wr * 64 + m * 16 + fr; const f32x2v sr = S[r]; const size_t off = (size_t)(u.pm * BM + r) * ldc + col0;
#pragma unroll
                for (int bj = 0; bj < 2; ++bj)
#pragma unroll
                    for (int n = 0; n < 2; ++n) { const f32x4 bs = *(const f32x4*)(base + off + bj * HALF + n * 16); acc[ai][bj][m][n] = bs + (acc[ai][bj][m][n] - sr.x) * sr.y; }
                asm volatile("" : "+v"(acc[ai][0][m][0]), "+v"(acc[ai][0][m][1]), "+v"(acc[ai][1][m][0]), "+v"(acc[ai][1][m][1]));
                if (m & 1) asm volatile("" ::: "memory"); }
        const bool bad1 = bad;
        bad = st2.run(acc, u, wr, wc, fr, fq, lds, wid, lane) || bad;
#pragma unroll
        for (int ai = 0; ai < 2; ++ai)
#pragma unroll
            for (int m = 0; m < 4; ++m) { const int r = ai * HALF + wr * 64 + m * 16 + fr; const f32x2v sr = S[r]; const size_t off = (size_t)(u.pm * BM + r) * ldc + col0;
#pragma unroll
                for (int bj = 0; bj < 2; ++bj)
#pragma unroll
                    for (int n = 0; n < 2; ++n) { const f32x4 x1 = acc[ai][bj][m][n]; *(f32x4*)(out + off + bj * HALF + n * 16) = bad1 ? (f32x4){qnan, qnan, qnan, qnan} : x1;
                        const f32x4 o = (x1 - sr.x) * sr.y; u32x2v w; w.x = cvt_pk_bf16(o[0], o[1]); w.y = cvt_pk_bf16(o[2], o[3]);
                        if (bad) { w.x = 0x7fc07fc0u; w.y = 0x7fc07fc0u; } *(u32x2v*)(xn + off + bj * HALF + n * 16) = w; }
                asm volatile("" ::: "memory"); }
    }
};

template <class Epi, class Sched, bool ALIGN_EPI = false, bool SP2 = false>
__device__ __forceinline__ void gemm_phase(PG8_LAS unsigned char* lds, const Gemm g, const Sched& S, const Epi& E) {
    const int tid = threadIdx.x, wid = __builtin_amdgcn_readfirstlane(tid >> 6), lane = tid & 63, wr = wid >> 2, wc = wid & 3, fr = lane & 15, fq = lane >> 4;
    const int K = g.K, nt = K / BK;
    unsigned voffA[2], voffB[2];
#pragma unroll
    for (int i = 0; i < 2; ++i) { int R, C; stage_rc(tid * 16 + i * 8192, R, C); const int Rb = Epi::PERM ? ((R & ~31) + perm32(R & 31)) : R;
        voffA[i] = (unsigned)(R * K + C) * 2u; voffB[i] = (unsigned)(Rb * K + C) * 2u; }
    const size_t kstep = (size_t)(BK * 2);
    const size_t hstep = (size_t)HALF * K * 2;
    const size_t tstep = 2 * hstep;
    const unsigned ldsw = (unsigned)wid * 1024u;
    const int aoff = lds_byte(wr * 64 + fr, fq * 8), boff = lds_byte(wc * 32 + fr, fq * 8);
#define PG8_SA(b, h) (((b) * 2 + (h)) * HTB)
#define PG8_SB(b, h) ((4 + (b) * 2 + (h)) * HTB)
#define PG8_STAGE(bufoff, gbase, voff) do { _Pragma("unroll") for (int _i = 0; _i < 2; ++_i) \
        __builtin_amdgcn_global_load_lds((const unsigned*)((const char*)(gbase) + (voff)[_i]), (PG8_LAS unsigned*)(lds + (bufoff) + ldsw + _i * 8192), 16, 0, 0); } while (0)
#define PG8_LDA(dst, b, h) do { _Pragma("unroll") for (int m = 0; m < 4; ++m) _Pragma("unroll") for (int k = 0; k < 2; ++k) dst[m][k] = *(const PG8_LAS bf16x8*)(lds + PG8_SA(b, h) + aoff + m * 2048 + k * 1024); } while (0)
#define PG8_LDB(dst, b, h) do { _Pragma("unroll") for (int n = 0; n < 2; ++n) _Pragma("unroll") for (int k = 0; k < 2; ++k) dst[n][k] = *(const PG8_LAS bf16x8*)(lds + PG8_SB(b, h) + boff + n * 2048 + k * 1024); } while (0)
#define PG8_MMA(ai, bj, At, Bt) do { __builtin_amdgcn_s_setprio(1); _Pragma("unroll") for (int m = 0; m < 4; ++m) _Pragma("unroll") for (int n = 0; n < 2; ++n) _Pragma("unroll") for (int k = 0; k < 2; ++k) \
        acc[ai][bj][m][n] = __builtin_amdgcn_mfma_f32_16x16x32_bf16(Bt[n][k], At[m][k], acc[ai][bj][m][n], 0, 0, 0); __builtin_amdgcn_s_setprio(0); } while (0)
#define PG8_WAIT_V(n) asm volatile("s_waitcnt vmcnt(" #n ")" ::: "memory")
#define PG8_WAIT_L(n) asm volatile("s_waitcnt lgkmcnt(" #n ")" ::: "memory")
#define PG8_BAR __builtin_amdgcn_s_barrier()
#define PG8_SCHED __builtin_amdgcn_sched_barrier(0)
    Unit cur, nxt; int ui = 0;
    if (!S.next(0, cur)) return;
    f32x4 acc[2][2][4][2];
#pragma unroll
    for (int a = 0; a < 2; ++a)
#pragma unroll
        for (int b = 0; b < 2; ++b)
#pragma unroll
            for (int m = 0; m < 4; ++m)
#pragma unroll
                for (int n = 0; n < 2; ++n) acc[a][b][m][n] = (f32x4){0.f, 0.f, 0.f, 0.f};
    bf16x8 At[4][2], B0[2][2], B1[2][2];
    const char* cA = (const char*)g.A + (size_t)cur.pm * tstep; const char* cB = (const char*)g.Bt + (size_t)cur.pn * tstep;
    S.a_ready(cur);
    if constexpr (SP2) {
        PG8_STAGE(PG8_SB(0, 0), cB, voffB); PG8_STAGE(PG8_SB(0, 1), cB + hstep, voffB); PG8_STAGE(PG8_SA(0, 0), cA, voffA); PG8_STAGE(PG8_SA(0, 1), cA + hstep, voffA);
        if (wr == 1) PG8_BAR;
        PG8_WAIT_V(2); PG8_BAR;
        PG8_STAGE(PG8_SB(1, 0), cB + kstep, voffB); PG8_STAGE(PG8_SA(1, 0), cA + kstep, voffA); PG8_STAGE(PG8_SB(1, 1), cB + hstep + kstep, voffB);
        PG8_WAIT_V(6); PG8_BAR;
    } else {
        PG8_STAGE(PG8_SB(0, 0), cB, voffB); PG8_STAGE(PG8_SA(0, 0), cA, voffA); PG8_STAGE(PG8_SB(0, 1), cB + hstep, voffB); PG8_STAGE(PG8_SA(0, 1), cA + hstep, voffA);
        if (wr == 1) PG8_BAR;
        PG8_WAIT_V(4); PG8_BAR;
        PG8_STAGE(PG8_SB(1, 0), cB + kstep, voffB); PG8_STAGE(PG8_SA(1, 0), cA + kstep, voffA); PG8_STAGE(PG8_SB(1, 1), cB + hstep + kstep, voffB);
        PG8_WAIT_V(6); PG8_BAR;
    }
    for (;;) {
        const bool has_next = S.next(ui + 1, nxt);
        const char* nA = has_next ? (const char*)g.A + (size_t)nxt.pm * tstep : cA; const char* nB = has_next ? (const char*)g.Bt + (size_t)nxt.pn * tstep : cB;
        for (int t = 0; t < nt; t += 2) {
            const bool last = (t == nt - 2);
            const char* a1 = cA + (size_t)(t + 1) * kstep;
            const char* a2 = last ? nA : cA + (size_t)(t + 2) * kstep; const char* b2 = last ? nB : cB + (size_t)(t + 2) * kstep;
            const char* a3 = a2 + kstep; const char* b3 = b2 + kstep;
            if (last && has_next) S.a_ready(nxt);
            if constexpr (SP2) {
            PG8_LDB(B0, 0, 0); PG8_LDB(B1, 0, 1); PG8_SCHED; PG8_LDA(At, 0, 0); PG8_STAGE(PG8_SA(1, 1), a1 + hstep, voffA);
            PG8_WAIT_V(8); PG8_WAIT_L(0); PG8_BAR; PG8_MMA(0, 0, At, B0); PG8_MMA(0, 1, At, B1); PG8_BAR; PG8_SCHED;
            PG8_LDA(At, 0, 1); PG8_STAGE(PG8_SB(0, 0), b2, voffB); PG8_STAGE(PG8_SB(0, 1), b2 + hstep, voffB); PG8_STAGE(PG8_SA(0, 0), a2, voffA);
            PG8_WAIT_V(8); PG8_WAIT_L(0); PG8_BAR; PG8_MMA(1, 0, At, B0); PG8_MMA(1, 1, At, B1); PG8_BAR; PG8_SCHED;
            PG8_LDB(B0, 1, 0); PG8_LDB(B1, 1, 1); PG8_SCHED; PG8_LDA(At, 1, 0); PG8_STAGE(PG8_SA(0, 1), a2 + hstep, voffA);
            PG8_WAIT_V(8); PG8_WAIT_L(0); PG8_BAR; PG8_MMA(0, 0, At, B0); PG8_MMA(0, 1, At, B1); PG8_BAR; PG8_SCHED;
            PG8_LDA(At, 1, 1); PG8_STAGE(PG8_SB(1, 0), b3, voffB); PG8_STAGE(PG8_SB(1, 1), b3 + hstep, voffB); PG8_STAGE(PG8_SA(1, 0), a3, voffA);
            PG8_WAIT_V(8); PG8_WAIT_L(0); PG8_BAR; PG8_MMA(1, 0, At, B0); PG8_MMA(1, 1, At, B1); PG8_BAR; PG8_SCHED;
            } else {
            PG8_LDB(B0, 0, 0); PG8_SCHED; PG8_LDA(At, 0, 0); PG8_STAGE(PG8_SA(1, 1), a1 + hstep, voffA);
            PG8_WAIT_L(8); PG8_BAR; PG8_WAIT_L(0); PG8_MMA(0, 0, At, B0); PG8_BAR; PG8_SCHED;
            PG8_LDB(B1, 0, 1); PG8_STAGE(PG8_SB(0, 0), b2, voffB);
            PG8_BAR; PG8_WAIT_L(0); PG8_MMA(0, 1, At, B1); PG8_BAR;
            PG8_LDA(At, 0, 1); PG8_STAGE(PG8_SA(0, 0), a2, voffA);
            PG8_BAR; PG8_WAIT_L(0); PG8_MMA(1, 0, At, B0); PG8_BAR; PG8_SCHED;
            PG8_STAGE(PG8_SB(0, 1), b2 + hstep, voffB);
            PG8_WAIT_V(6); PG8_BAR; PG8_MMA(1, 1, At, B1); PG8_BAR;
            PG8_LDB(B0, 1, 0); PG8_SCHED; PG8_LDA(At, 1, 0); PG8_STAGE(PG8_SA(0, 1), a2 + hstep, voffA);
            PG8_WAIT_L(8); PG8_BAR; PG8_WAIT_L(0); PG8_MMA(0, 0, At, B0); PG8_BAR; PG8_SCHED;
            PG8_LDB(B1, 1, 1); PG8_STAGE(PG8_SB(1, 0), b3, voffB);
            PG8_BAR; PG8_WAIT_L(0); PG8_MMA(0, 1, At, B1); PG8_BAR;
            PG8_LDA(At, 1, 1); PG8_STAGE(PG8_SA(1, 0), a3, voffA);
            PG8_BAR; PG8_WAIT_L(0); PG8_MMA(1, 0, At, B0); PG8_BAR; PG8_SCHED;
            PG8_STAGE(PG8_SB(1, 1), b3 + hstep, voffB);
            PG8_WAIT_V(6); PG8_BAR; PG8_MMA(1, 1, At, B1); PG8_BAR;
            }
        }
        if constexpr (ALIGN_EPI) { if (wr == 0) PG8_BAR; }
        if constexpr (!Epi::AFTER_DRAIN) { E(acc, cur, wr, wc, fr, fq); S.done(cur); }
        if (!has_next) break;
#pragma unroll
        for (int a = 0; a < 2; ++a)
#pragma unroll
            for (int b = 0; b < 2; ++b)
#pragma unroll
                for (int m = 0; m < 4; ++m)
#pragma unroll
                    for (int n = 0; n < 2; ++n) acc[a][b][m][n] = (f32x4){0.f, 0.f, 0.f, 0.f};
        cur = nxt; cA = nA; cB = nB; ++ui;
        if constexpr (ALIGN_EPI) { if (wr == 1) PG8_BAR; }
    }
    PG8_WAIT_V(0);
    if constexpr (!ALIGN_EPI) { if (wr == 0) PG8_BAR; }
    PG8_BAR;
    if constexpr (Epi::AFTER_DRAIN) { E.fused(acc, cur, wr, wc, fr, fq, lds, wid, lane); S.done(cur); }
#undef PG8_SA
#undef PG8_SB
#undef PG8_STAGE
#undef PG8_LDA
#undef PG8_LDB
#undef PG8_MMA
#undef PG8_WAIT_V
#undef PG8_WAIT_L
#undef PG8_BAR
#undef PG8_SCHED
}
}
constexpr int D = 1024, SEQ = 8192, BATCH = 2, MROWS = BATCH * SEQ, DFF = 4096, NINP = 4608;
constexpr int NCMP = 511;
constexpr float ALPHA = 1.189207115002721f;
constexpr float LN_EPS = 1e-5f;
constexpr int LDS_BYTES = 147456;
constexpr int NT = 512;
constexpr size_t MiB = 1u << 20;
constexpr size_t WS_WIN = 1 * MiB, WS_WPGM = 15 * MiB, WS_WPNSA = 17 * MiB, WS_WOUT = 19 * MiB, WS_WFF1 = 21 * MiB, WS_WFF2 = 29 * MiB;
constexpr size_t WS_W1K = 37 * MiB, WS_W1V = 38 * MiB, WS_KC = 39 * MiB, WS_VC = 39 * MiB + 512 * 1024, WS_STATS = 40 * MiB, WS_G = 41 * MiB;
constexpr size_t WS_XB = 42 * MiB, WS_U = 74 * MiB, WS_V = 106 * MiB, WS_Q = 138 * MiB, WS_KV = 170 * MiB;
constexpr size_t WS_WG = 40 * MiB + 256 * 1024, WS_W2K = 40 * MiB + 512 * 1024, WS_W2V = 40 * MiB + 544 * 1024, WS_WSC = 40 * MiB + 768 * 1024;
constexpr size_t WS_T = WS_Q, WS_S = WS_KV, WS_MERGED = WS_V, WS_HB = WS_XB, WS_A = 74 * MiB, WS_YN = 218 * MiB;
typedef unsigned short bf16;
typedef unsigned u32x4 __attribute__((ext_vector_type(4)));
typedef float f32x4 __attribute__((ext_vector_type(4)));

struct Params {
  const float* x; const float* w_in; const float* gm_ln_g; const float* gm_ln_b; const float* gm_w_s; const float* gm_b_s;
  const float* pe_k; const float* w1_k; const float* w2_k; const float* pe_v; const float* w1_v; const float* w2_v;
  const float* w_pgm; const float* w_pnsa; const float* w_out; const float* ln1_g; const float* ln1_b;
  const float* w_ff1; const float* w_ff2; const float* ln2_g; const float* ln2_b;
  float* out; unsigned char* ws; int ph_lo, ph_hi;
};

__device__ __forceinline__ int tid_l() { int t = threadIdx.x; asm volatile("" : "+v"(t)); return t; }
__device__ __forceinline__ int bid_l() { int t = blockIdx.x; asm volatile("" : "+s"(t)); return t; }
__device__ __forceinline__ float wave_sum(float v) {
#pragma unroll
  for (int o = 1; o < 64; o <<= 1) v += __shfl_xor(v, o);
  return v;
}
__device__ __forceinline__ float wave_max(float v) {
#pragma unroll
  for (int o = 1; o < 64; o <<= 1) v = fmaxf(v, __shfl_xor(v, o));
  return v;
}
__device__ __forceinline__ float gelu_tanh(float x) {
  const float c = 0.7978845608028654f;
  return 0.5f * x * (1.0f + tanhf(c * (x + 0.044715f * x * x * x)));
}
__device__ __forceinline__ float sigmoidf_(float x) { return 1.0f / (1.0f + expf(-x)); }
__device__ __forceinline__ unsigned f2bf(float f) { unsigned u = __builtin_bit_cast(unsigned, f); return (u + 0x7fffu + ((u >> 16) & 1u)) >> 16; }
__device__ __forceinline__ unsigned pk2(float lo, float hi) { return f2bf(lo) | (f2bf(hi) << 16); }
__device__ __forceinline__ float bf2f(bf16 v) { return __builtin_bit_cast(float, (unsigned)v << 16); }
__device__ __forceinline__ float bflo(unsigned w) { return __builtin_bit_cast(float, w << 16); }
__device__ __forceinline__ float bfhi(unsigned w) { return __builtin_bit_cast(float, w & 0xffff0000u); }

namespace pg8 {
__device__ __forceinline__ f32x2 gelu_tanh_pk(f32x2 v) {
  const f32x2 u = v * ((v * v) * 0.044715f + 1.0f);
  const f32x2 s = u * (-2.0f * 0.7978845608028654f * 1.4426950408889634f);
  f32x2 e; e.x = __builtin_amdgcn_exp2f(s.x); e.y = __builtin_amdgcn_exp2f(s.y);
  const f32x2 d = e + 1.0f; f32x2 r; r.x = __builtin_amdgcn_rcpf(d.x); r.y = __builtin_amdgcn_rcpf(d.y);
  return v * r;
}
__device__ __forceinline__ f32x2 sigmoid_pk(f32x2 v) {
  const f32x2 s = v * (-1.4426950408889634f);
  f32x2 e; e.x = __builtin_amdgcn_exp2f(s.x); e.y = __builtin_amdgcn_exp2f(s.y);
  const f32x2 d = e + 1.0f; f32x2 r; r.x = __builtin_amdgcn_rcpf(d.x); r.y = __builtin_amdgcn_rcpf(d.y);
  return r;
}
template <int ACT> __device__ __forceinline__ void act8(f32x4& v0, f32x4& v1) {
  if (ACT == 1) { f32x2 a = gelu_tanh_pk((f32x2){v0[0], v0[1]}), b = gelu_tanh_pk((f32x2){v0[2], v0[3]}), c = gelu_tanh_pk((f32x2){v1[0], v1[1]}), d = gelu_tanh_pk((f32x2){v1[2], v1[3]});
    v0 = (f32x4){a.x, a.y, b.x, b.y}; v1 = (f32x4){c.x, c.y, d.x, d.y}; }
  if (ACT == 2) { v0 = v0 * 0.08838834764831845f; v1 = v1 * 0.08838834764831845f; }
  if (ACT == 3) { f32x2 a = sigmoid_pk((f32x2){v0[0], v0[1]}), b = sigmoid_pk((f32x2){v0[2], v0[3]}), c = sigmoid_pk((f32x2){v1[0], v1[1]}), d = sigmoid_pk((f32x2){v1[2], v1[3]});
    v0 = (f32x4){a.x, a.y, b.x, b.y}; v1 = (f32x4){c.x, c.y, d.x, d.y}; }
  if (ACT == 4) { const f32x4 z = {0.f, 0.f, 0.f, 0.f}; v0 = __builtin_elementwise_max(v0, z); v1 = __builtin_elementwise_max(v1, z); v0 = v0 * v0; v1 = v1 * v1; }
}
__device__ __forceinline__ u32x4 pack8(const f32x4 v0, const f32x4 v1) { u32x4 w; w.x = cvt_pk_bf16(v0[0], v0[1]); w.y = cvt_pk_bf16(v0[2], v0[3]); w.z = cvt_pk_bf16(v1[0], v1[1]); w.w = cvt_pk_bf16(v1[2], v1[3]); return w; }
__device__ __forceinline__ void unpack8(const u32x4 w, f32x4& v0, f32x4& v1) { v0 = (f32x4){bflo(w.x), bfhi(w.x), bflo(w.y), bfhi(w.y)}; v1 = (f32x4){bflo(w.z), bfhi(w.z), bflo(w.w), bfhi(w.w)}; }

template <int ACT> __device__ __forceinline__ void store_tile_bf16(const f32x4 (&acc)[2][2][4][2], bf16_t* base, int ldc, int row0, int cl0, int ncl) {
#pragma unroll
  for (int ai = 0; ai < 2; ++ai)
#pragma unroll
    for (int m = 0; m < 4; ++m) { bf16_t* rowp = base + (size_t)(row0 + ai * HALF + m * 16) * ldc + cl0;
#pragma unroll
      for (int bj = 0; bj < 2; ++bj) { f32x4 v0 = acc[ai][bj][m][0], v1 = acc[ai][bj][m][1]; act8<ACT>(v0, v1);
        if (cl0 + bj * HALF < ncl) *(u32x4*)(rowp + bj * HALF) = pack8(v0, v1); } }
}
struct EpiIn {
  static constexpr bool PERM = true, AFTER_DRAIN = false;
  bf16_t *U, *V, *Q, *KV;
  __device__ __forceinline__ void operator()(const f32x4 (&acc)[2][2][4][2], const Unit& u, int wr, int wc, int fr, int fq) const {
    const int pn = u.pn, row0 = u.pm * BM + wr * 64 + fr, cl0 = wc * 32 + 8 * fq;
    if (pn < 4) store_tile_bf16<1>(acc, U + pn * 256, 1024, row0, cl0, 256);
    else if (pn < 8) store_tile_bf16<1>(acc, V + (pn - 4) * 256, 1024, row0, cl0, 256);
    else if (pn < 12) store_tile_bf16<2>(acc, Q + (pn - 8) * 256, 1024, row0, cl0, 256);
    else store_tile_bf16<0>(acc, KV + (size_t)(pn - 12) * MROWS * 256, 256, row0, cl0, 256);
  }
};
template <int MODE> struct EpiMix {
  static constexpr bool PERM = true, AFTER_DRAIN = false;
  bf16_t* O; int ldc; const bf16_t* T; const bf16_t* S;
  __device__ __forceinline__ void operator()(const f32x4 (&acc)[2][2][4][2], const Unit& u, int wr, int wc, int fr, int fq) const {
    const int row0 = u.pm * BM + wr * 64 + fr, col0 = u.pn * BM + wc * 32 + 8 * fq;
#pragma unroll
    for (int ai = 0; ai < 2; ++ai)
#pragma unroll
      for (int m = 0; m < 4; ++m) { const size_t row = (size_t)(row0 + ai * HALF + m * 16);
#pragma unroll
        for (int bj = 0; bj < 2; ++bj) { f32x4 v0 = acc[ai][bj][m][0], v1 = acc[ai][bj][m][1]; const size_t off = row * ldc + col0 + bj * HALF;
          if (MODE == 0) act8<4>(v0, v1);
          if (MODE == 3) act8<3>(v0, v1);
          if (MODE == 5) { f32x4 s0, s1; unpack8(*(const u32x4*)(S + off), s0, s1); v0 = v0 * s0; v1 = v1 * s1; }
          if (MODE == 4) { f32x4 t0, t1; unpack8(*(const u32x4*)(T + off), t0, t1); v0 = v0 * t0; v1 = v1 * t1; }
          if (MODE == 5) { f32x4 t0, t1; unpack8(*(const u32x4*)(T + off), t0, t1); v0 = v0 + t0; v1 = v1 + t1; }
          *(u32x4*)(O + off) = pack8(v0, v1); } }
  }
};
struct EpiRes {
  static constexpr bool PERM = true, AFTER_DRAIN = false;
  float* O; const float* R;
  __device__ __forceinline__ void operator()(const f32x4 (&acc)[2][2][4][2], const Unit& u, int wr, int wc, int fr, int fq) const {
    const int row0 = u.pm * BM + wr * 64 + fr, col0 = u.pn * BM + wc * 32 + 8 * fq;
#pragma unroll
    for (int ai = 0; ai < 2; ++ai)
#pragma unroll
      for (int m = 0; m < 4; ++m) { const size_t row = (size_t)(row0 + ai * HALF + m * 16);
#pragma unroll
        for (int bj = 0; bj < 2; ++bj) { const size_t off = row * 1024 + col0 + bj * HALF;
          const f32x4 r0 = *(const f32x4*)(R + off), r1 = *(const f32x4*)(R + off + 4);
          *(f32x4*)(O + off) = r0 * ALPHA + acc[ai][bj][m][0]; *(f32x4*)(O + off + 4) = r1 * ALPHA + acc[ai][bj][m][1]; } }
  }
};
}

#define LAS __attribute__((address_space(3)))
#define GAS __attribute__((address_space(1)))
#define LDS_WAIT() asm volatile("s_waitcnt lgkmcnt(0)" ::: "memory")

__device__ __forceinline__ void p0_transpose_item(const float* W, int ldw, int src_col0, int nvalid, int ncols, int K, bf16* WT, int dst_row0, LAS float* scr, int item, int lane) {
  const int nblk = ncols / 32, kb = item / nblk, nb = item % nblk, k0 = 64 * kb, n0 = 32 * nb;
  const int nn = n0 + (lane & 31);
#pragma unroll 8
  for (int i = 0; i < 32; ++i) { const int kk = 2 * i + (lane >> 5); scr[kk * 33 + (lane & 31)] = (nn < nvalid) ? W[(size_t)(k0 + kk) * ldw + src_col0 + nn] : 0.f; }
  LDS_WAIT(); asm volatile("" ::: "memory");
  const int c = lane & 7;
#pragma unroll
  for (int j = 0; j < 4; ++j) { const int n = (lane >> 3) + 8 * j; const LAS float* s = scr + (8 * c) * 33 + n;
    u32x4 o; o.x = pk2(s[0 * 33], s[1 * 33]); o.y = pk2(s[2 * 33], s[3 * 33]); o.z = pk2(s[4 * 33], s[5 * 33]); o.w = pk2(s[6 * 33], s[7 * 33]);
    *(u32x4*)(WT + (size_t)(dst_row0 + n0 + n) * K + k0 + 8 * c) = o; }
  LDS_WAIT(); asm volatile("" ::: "memory");
}
__device__ __forceinline__ void p0_prologue(const Params& p, unsigned char* lds_raw) {
  const int tid = tid_l(), bid = bid_l(), lane = tid & 63, wave = tid >> 6;
  LAS float* scr = (LAS float*)((LAS unsigned char*)lds_raw + wave * 16384);
  const int gw = bid * 8 + wave, NGW = gridDim.x * 8;
  unsigned char* ws = p.ws;
  constexpr int I_A = 16 * (4608 / 32), I_M = 16 * (2048 / 32), I_G = 16 * (256 / 32), I_P = 16 * (1024 / 32), I_1 = 16 * (4096 / 32), I_2 = 64 * (1024 / 32);
  constexpr int I_C1 = 64 * (128 / 32), I_C2 = 2 * (128 / 32);
  constexpr int NITEMS = I_A + I_M + I_G + 3 * I_P + I_1 + I_2 + 2 * I_C1 + 2 * I_C2;
  for (int it = gw; it < NITEMS; it += NGW) {
    int r = it;
    if (r < I_A) { p0_transpose_item(p.w_in, 6680, 0, 4608, 4608, 1024, (bf16*)(ws + WS_WIN), 0, scr, r, lane); continue; } r -= I_A;
    if (r < I_M) { p0_transpose_item(p.w_in, 6680, 4632, 2048, 2048, 1024, (bf16*)(ws + WS_WIN), 4608, scr, r, lane); continue; } r -= I_M;
    if (r < I_G) { p0_transpose_item(p.w_in, 6680, 4608, 24, 256, 1024, (bf16*)(ws + WS_WIN), 6656, scr, r, lane); continue; } r -= I_G;
    if (r < I_P) { p0_transpose_item(p.w_pgm, 1024, 0, 1024, 1024, 1024, (bf16*)(ws + WS_WPGM), 0, scr, r, lane); continue; } r -= I_P;
    if (r < I_P) { p0_transpose_item(p.w_pnsa, 1024, 0, 1024, 1024, 1024, (bf16*)(ws + WS_WPNSA), 0, scr, r, lane); continue; } r -= I_P;
    if (r < I_P) { p0_transpose_item(p.w_out, 1024, 0, 1024, 1024, 1024, (bf16*)(ws + WS_WOUT), 0, scr, r, lane); continue; } r -= I_P;
    if (r < I_1) { p0_transpose_item(p.w_ff1, 4096, 0, 4096, 4096, 1024, (bf16*)(ws + WS_WFF1), 0, scr, r, lane); continue; } r -= I_1;
    if (r < I_2) { p0_transpose_item(p.w_ff2, 1024, 0, 1024, 1024, 4096, (bf16*)(ws + WS_WFF2), 0, scr, r, lane); continue; } r -= I_2;
    if (r < I_C1) { p0_transpose_item(p.w1_k, 128, 0, 128, 128, 4096, (bf16*)(ws + WS_W1K), 0, scr, r, lane); continue; } r -= I_C1;
    if (r < I_C1) { p0_transpose_item(p.w1_v, 128, 0, 128, 128, 4096, (bf16*)(ws + WS_W1V), 0, scr, r, lane); continue; } r -= I_C1;
    if (r < I_C2) { p0_transpose_item(p.w2_k, 128, 0, 128, 128, 128, (bf16*)(ws + WS_W2K), 0, scr, r, lane); continue; } r -= I_C2;
    p0_transpose_item(p.w2_v, 128, 0, 128, 128, 128, (bf16*)(ws + WS_W2V), 0, scr, r, lane);
  }
  { bf16* WSC = (bf16*)(ws + WS_WSC); for (int i = bid * NT + tid; i < 8 * 128 * 128; i += gridDim.x * NT) { const int ii = (i >> 7) & 127, jj = i & 127; WSC[i] = (bf16)f2bf(jj <= ii ? p.gm_w_s[i] : 0.f); } }
  { float* WG = (float*)(ws + WS_WG); for (int i = bid * NT + tid; i < 1024 * 24; i += gridDim.x * NT) WG[i] = p.w_in[(size_t)(i / 24) * 6680 + 4608 + (i % 24)]; }
  bf16* XB = (bf16*)(ws + WS_XB);
  const size_t n8 = (size_t)MROWS * D / 8;
  for (size_t i = (size_t)bid * NT + tid; i < n8; i += (size_t)gridDim.x * NT) {
    const f32x4 a = *(const f32x4*)(p.x + i * 8), b = *(const f32x4*)(p.x + i * 8 + 4);
    u32x4 o; o.x = pk2(a[0], a[1]); o.y = pk2(a[2], a[3]); o.z = pk2(b[0], b[1]); o.w = pk2(b[2], b[3]);
    *(u32x4*)(XB + i * 8) = o;
  }
}

__device__ __forceinline__ void vstats_phase(const bf16* V, float* stats) {
  const int tid = tid_l(), lane = tid & 63, gw = bid_l() * (NT / 64) + (tid >> 6), ngw = gridDim.x * (NT / 64);
  for (int r = gw; r < MROWS; r += ngw) {
    const bf16* v = V + (size_t)r * 1024;
    float vv[16]; float s = 0.f;
#pragma unroll
    for (int h = 0; h < 2; ++h) { const u32x4 w = *(const u32x4*)(v + h * 512 + lane * 8);
      vv[h * 8 + 0] = bflo(w.x); vv[h * 8 + 1] = bfhi(w.x); vv[h * 8 + 2] = bflo(w.y); vv[h * 8 + 3] = bfhi(w.y); vv[h * 8 + 4] = bflo(w.z); vv[h * 8 + 5] = bfhi(w.z); vv[h * 8 + 6] = bflo(w.w); vv[h * 8 + 7] = bfhi(w.w); }
#pragma unroll
    for (int i = 0; i < 16; ++i) s += vv[i];
    const float mu = wave_sum(s) * (1.f / 1024.f);
    float q = 0.f;
#pragma unroll
    for (int i = 0; i < 16; ++i) { const float d = vv[i] - mu; q += d * d; }
    const float var = wave_sum(q) * (1.f / 1024.f);
    if (lane == 0) { stats[2 * r] = mu; stats[2 * r + 1] = 1.0f / sqrtf(var + LN_EPS); }
  }
}
__device__ __forceinline__ void ln_rows_phase(float* X, const float* g, const float* b, bf16* XBo) {
  const int tid = tid_l(), lane = tid & 63, gw = bid_l() * (NT / 64) + (tid >> 6), ngw = gridDim.x * (NT / 64);
  for (int r = gw; r < MROWS; r += ngw) {
    float* x = X + (size_t)r * D;
    f32x4 vv[4]; float s = 0.f;
#pragma unroll
    for (int i = 0; i < 4; ++i) { vv[i] = *(const f32x4*)(x + i * 256 + lane * 4); s += (vv[i][0] + vv[i][1]) + (vv[i][2] + vv[i][3]); }
    const float mu = wave_sum(s) * (1.f / 1024.f);
    float q = 0.f;
#pragma unroll
    for (int i = 0; i < 4; ++i) { const f32x4 d = vv[i] - mu; q += (d[0] * d[0] + d[1] * d[1]) + (d[2] * d[2] + d[3] * d[3]); }
    const float rstd = 1.0f / sqrtf(wave_sum(q) * (1.f / 1024.f) + LN_EPS);
#pragma unroll
    for (int i = 0; i < 4; ++i) { const int c = i * 256 + lane * 4; const f32x4 gg = *(const f32x4*)(g + c), bb = *(const f32x4*)(b + c);
      const f32x4 o = (vv[i] - mu) * rstd * gg + bb; *(f32x4*)(x + c) = o;
      if (XBo) { uint2 w; w.x = pk2(o[0], o[1]); w.y = pk2(o[2], o[3]); *(uint2*)(XBo + (size_t)r * D + c) = w; } }
  }
}
__device__ __forceinline__ void gmlp_naive_phase(float* lds, bf16* U, const bf16* V, const float* stats, const Params& p) {
  const int tid = tid_l(), bid = bid_l();
  float* lv = lds;
  const int nitems = (MROWS / 128) * 8;
  for (int it = bid; it < nitems; it += gridDim.x) {
    const int n = it >> 3, g = it & 7;
    const int r0 = n * 128, c0 = g * 128;
    for (int e = tid; e < 128 * 128; e += NT) {
      const int j = e >> 7, d = e & 127;
      const float v = bf2f(V[(size_t)(r0 + j) * 1024 + c0 + d]);
      lv[e] = (v - stats[2 * (r0 + j)]) * stats[2 * (r0 + j) + 1] * p.gm_ln_g[c0 + d] + p.gm_ln_b[c0 + d];
    }
    __syncthreads();
    const int i = tid >> 2, dq = (tid & 3) * 32;
    float acc[32];
#pragma unroll
    for (int e = 0; e < 32; ++e) acc[e] = 0.f;
    const float* wrow = p.gm_w_s + ((size_t)g * 128 + i) * 128;
    for (int j = 0; j <= i; ++j) {
      const float w = wrow[j];
#pragma unroll
      for (int e = 0; e < 32; ++e) acc[e] = fmaf(w, lv[j * 128 + dq + e], acc[e]);
    }
    const float bs = p.gm_b_s[g * 128 + i];
    bf16* urow = U + (size_t)(r0 + i) * 1024 + c0 + dq;
#pragma unroll
    for (int e = 0; e < 32; ++e) urow[e] = (bf16)f2bf(bf2f(urow[e]) * (acc[e] + bs));
    __syncthreads();
  }
}
__device__ __forceinline__ void compress_naive_phase(float* lds, const bf16* KCin, const bf16* VCin, bf16* KC, bf16* VC, const Params& p) {
  const int tid = tid_l(), bid = bid_l(), sub = tid >> 7, t = tid & 127;
  float* flat = lds + sub * (4096 + 128);
  float* hid = flat + 4096;
  const int nitems = BATCH * NCMP * 2 * 2;
  const int nrounds = (nitems + 3) / 4;
  for (int rd = bid; rd < nrounds; rd += gridDim.x) {
    const int it = rd * 4 + sub;
    const bool ok = it < nitems;
    const int which = ok ? it / (BATCH * NCMP * 2) : 0, rem = ok ? it % (BATCH * NCMP * 2) : 0, b = rem / (NCMP * 2), r2 = rem % (NCMP * 2), i = r2 >> 1, h = r2 & 1;
    const float* pe = which ? p.pe_v : p.pe_k; const float* w1 = which ? p.w1_v : p.w1_k; const float* w2 = which ? p.w2_v : p.w2_k;
    const bf16* src = which ? VCin : KCin;
    for (int e = t; e < 4096; e += 128) { const int pp = e >> 7, d = e & 127; flat[e] = bf2f(src[(size_t)(b * SEQ + 16 * i + pp) * 256 + h * 128 + d]) + pe[pp * 128 + d]; }
    __syncthreads();
    float a = 0.f;
    for (int k = 0; k < 4096; ++k) a = fmaf(flat[k], w1[(size_t)k * 128 + t], a);
    hid[t] = gelu_tanh(a);
    __syncthreads();
    float o = 0.f;
    for (int k = 0; k < 128; ++k) o = fmaf(hid[k], w2[k * 128 + t], o);
    if (ok) (which ? VC : KC)[((size_t)(b * NCMP + i) * 2 + h) * 128 + t] = (bf16)f2bf(o);
    __syncthreads();
  }
}

namespace att {
typedef short bf16x8 __attribute__((ext_vector_type(8)));
typedef short s16x4 __attribute__((ext_vector_type(4)));
typedef float f32x16 __attribute__((ext_vector_type(16)));
#define ATT_MFMA(a, b, c) __builtin_amdgcn_mfma_f32_32x32x16_bf16((a), (b), (c), 0, 0, 0)
constexpr int KROW = 272, VROW = 72;
constexpr int KBUF = 32 * KROW, VBUF = 128 * VROW, TBUF = KBUF + VBUF;
constexpr int OFF_IMP = 2 * TBUF, OFF_SEL = OFF_IMP + 64 * 128 * 4, OFF_WU = OFF_SEL + 64 * 4 * 4, OFF_UL = OFF_WU + 256, OFF_Y = OFF_UL + 768, YROW = 272;
static_assert(OFF_Y + 256 * YROW <= 147456 - 64, "attention LDS map");
constexpr float LOG2E = 1.4426950408889634f;
__device__ __forceinline__ int crow(int i, int h) { return (i & 3) + 8 * (i >> 2) + 4 * h; }
__device__ __forceinline__ unsigned pkbf(float lo, float hi) {
  typedef __bf16 v2bf __attribute__((ext_vector_type(2))); typedef float v2f __attribute__((ext_vector_type(2)));
  const v2f f = {lo, hi}; const v2bf b = __builtin_convertvector(f, v2bf); return __builtin_bit_cast(unsigned, b);
}
__device__ __forceinline__ f32x16 qk_tile(const char* kb, const char* qb, int r, int h) {
  f32x16 x;
#pragma unroll
  for (int i = 0; i < 16; ++i) x[i] = 0.f;
#pragma unroll
  for (int ks = 0; ks < 8; ++ks) { const bf16x8 a = *(const bf16x8*)(kb + r * KROW + ks * 32 + h * 16); const bf16x8 bq = *(const bf16x8*)(qb + ks * 32); x = ATT_MFMA(a, bq, x); if (ks == 3) asm volatile("" ::: "memory"); }
  return x;
}
__device__ __forceinline__ void pv_tile(const char* vb, const f32x16& p, const float sc_, f32x16 (&o)[4], int r, int h) {
  u32x4 w0, w1;
  w0.x = pkbf(p[0] * sc_, p[1] * sc_); w0.y = pkbf(p[2] * sc_, p[3] * sc_); w0.z = pkbf(p[4] * sc_, p[5] * sc_); w0.w = pkbf(p[6] * sc_, p[7] * sc_);
  w1.x = pkbf(p[8] * sc_, p[9] * sc_); w1.y = pkbf(p[10] * sc_, p[11] * sc_); w1.z = pkbf(p[12] * sc_, p[13] * sc_); w1.w = pkbf(p[14] * sc_, p[15] * sc_);
  const bf16x8 ps0 = __builtin_bit_cast(bf16x8, w0), ps1 = __builtin_bit_cast(bf16x8, w1);
#pragma unroll
  for (int dt = 0; dt < 4; ++dt) {
    const char* vr = vb + (32 * dt + r) * VROW + 8 * h;
    const s16x4 a0 = *(const s16x4*)(vr), a1 = *(const s16x4*)(vr + 16), a2 = *(const s16x4*)(vr + 32), a3 = *(const s16x4*)(vr + 48);
    o[dt] = ATT_MFMA(__builtin_shufflevector(a0, a1, 0, 1, 2, 3, 4, 5, 6, 7), ps0, o[dt]);
    o[dt] = ATT_MFMA(__builtin_shufflevector(a2, a3, 0, 1, 2, 3, 4, 5, 6, 7), ps1, o[dt]);
    if (dt & 1) asm volatile("" ::: "memory");
  }
}
__device__ __forceinline__ void stage_store(char* buf, const u32x4 kreg, const u32x4 vreg, bool withv, int skk, int sc) {
  *(u32x4*)(buf + skk * KROW + sc * 16) = kreg;
  if (withv) {
    char* vb = buf + KBUF + (8 * sc) * VROW + skk * 2;
    *(unsigned short*)(vb + 0 * VROW) = (unsigned short)(vreg.x & 0xffffu); *(unsigned short*)(vb + 1 * VROW) = (unsigned short)(vreg.x >> 16);
    *(unsigned short*)(vb + 2 * VROW) = (unsigned short)(vreg.y & 0xffffu); *(unsigned short*)(vb + 3 * VROW) = (unsigned short)(vreg.y >> 16);
    *(unsigned short*)(vb + 4 * VROW) = (unsigned short)(vreg.z & 0xffffu); *(unsigned short*)(vb + 5 * VROW) = (unsigned short)(vreg.z >> 16);
    *(unsigned short*)(vb + 6 * VROW) = (unsigned short)(vreg.w & 0xffffu); *(unsigned short*)(vb + 7 * VROW) = (unsigned short)(vreg.w >> 16);
  }
}
#define ATT_TILE_LOOP(NTILES, ROW0, ROWMAX, KB, VB, WITHV, ...) do { const int nt_ = (NTILES); if (nt_ > 0) { u32x4 kreg_, vreg_ = {0u, 0u, 0u, 0u}; \
    { const int i_ = 0; const int row_ = max(min((ROW0) + skk, (ROWMAX)), 0); kreg_ = *(const u32x4*)((KB) + (size_t)row_ * 256 + sc * 8); if (WITHV) vreg_ = *(const u32x4*)((VB) + (size_t)row_ * 256 + sc * 8); } \
    stage_store(lds, kreg_, vreg_, WITHV, skk, sc); __syncthreads(); \
    for (int ti_ = 0; ti_ < nt_; ++ti_) { const char* buf_ = lds + (ti_ & 1) * TBUF; \
      if (ti_ + 1 < nt_) { const int i_ = ti_ + 1; const int row_ = max(min((ROW0) + skk, (ROWMAX)), 0); kreg_ = *(const u32x4*)((KB) + (size_t)row_ * 256 + sc * 8); if (WITHV) vreg_ = *(const u32x4*)((VB) + (size_t)row_ * 256 + sc * 8); } \
      { const int i_ = ti_; __VA_ARGS__ } \
      if (ti_ + 1 < nt_) stage_store(lds + ((ti_ + 1) & 1) * TBUF, kreg_, vreg_, WITHV, skk, sc); \
      __syncthreads(); } } } while (0)
#define ATT_PASS1_UPDATE(MC, LC) do { float tmax_ = -1e30f; _Pragma("unroll") for (int i = 0; i < 16; ++i) tmax_ = fmaxf(tmax_, sv[i]); \
    tmax_ = fmaxf(tmax_, __shfl_xor(tmax_, 32)); const float mn_ = fmaxf((MC), tmax_); float sum_ = 0.f; \
    _Pragma("unroll") for (int i = 0; i < 16; ++i) sum_ += (sv[i] > -1e29f) ? __builtin_amdgcn_exp2f(sv[i] - mn_) : 0.f; \
    sum_ += __shfl_xor(sum_, 32); (LC) = (LC) * __builtin_amdgcn_exp2f((MC) - mn_) + sum_; (MC) = mn_; } while (0)

__device__ __forceinline__ void attn_phase(char* lds, const bf16* Q, bf16* YN, const bf16* KVb, const float* X, const float* WG, const bf16* KC, const bf16* VC) {
  const int tid = tid_l(), bid = bid_l(), lane = tid & 63, w = __builtin_amdgcn_readfirstlane(tid >> 6), r = lane & 31, h = lane >> 5;
  const int R = 32 * w + r, qq = R >> 2, g = R & 3;
  const int skk = tid >> 4, sc = tid & 15;
  float* imp = (float*)(lds + OFF_IMP); unsigned* selm = (unsigned*)(lds + OFF_SEL); unsigned* wun = (unsigned*)(lds + OFF_WU); int* ulist = (int*)(lds + OFF_UL);
  for (int pass_u = 0; pass_u < 2; ++pass_u) {
    const int uidx = pass_u == 0 ? bid : 511 - bid;
    if (uidx < 0 || uidx >= 512 || (pass_u == 1 && uidx == bid)) continue;
    const int qb = uidx >> 2, b = (uidx >> 1) & 1, kv = uidx & 1;
    const int q0 = qb * 64, t = q0 + qq, head = kv * 4 + g;
    const int tw_lo = q0 + 8 * w, tw_hi = tw_lo + 7;
    const size_t rowg = (size_t)b * SEQ + t;
    char* const qrow_l = lds + OFF_Y + R * YROW + h * 16;
#pragma unroll
    for (int ks = 0; ks < 8; ++ks) *(bf16x8*)(qrow_l + ks * 32) = *(const bf16x8*)(Q + rowg * 1024 + head * 128 + ks * 16 + h * 8);
    float g0, g1, g2;
    { const float* xr = X + rowg * 1024 + h * 512; const float* wg = WG + (size_t)h * 512 * 24 + head * 3; float a0 = 0.f, a1 = 0.f, a2 = 0.f;
      for (int k = 0; k < 512; k += 4) { const f32x4 xv = *(const f32x4*)(xr + k);
#pragma unroll
        for (int e = 0; e < 4; ++e) { const float* wk = wg + (k + e) * 24; a0 = fmaf(xv[e], wk[0], a0); a1 = fmaf(xv[e], wk[1], a1); a2 = fmaf(xv[e], wk[2], a2); } }
      a0 += __shfl_xor(a0, 32); a1 += __shfl_xor(a1, 32); a2 += __shfl_xor(a2, 32);
      g0 = 1.0f / (1.0f + __expf(-a0)); g1 = 1.0f / (1.0f + __expf(-a1)); g2 = 1.0f / (1.0f + __expf(-a2)); }
    const float slope2 = exp2f(-(float)(head + 1)) * LOG2E;
    for (int i = tid; i < 64 * 128; i += NT) imp[i] = 0.f;
    f32x16 o[4];
#pragma unroll
    for (int dt = 0; dt < 4; ++dt)
#pragma unroll
      for (int i = 0; i < 16; ++i) o[dt][i] = 0.f;
    const bf16* KCb = KC + (size_t)b * NCMP * 256 + kv * 128; const bf16* VCb = VC + (size_t)b * NCMP * 256 + kv * 128;
    const bf16* KS = KVb + (size_t)2 * MROWS * 256 + (size_t)b * SEQ * 256 + kv * 128; const bf16* VS = KVb + (size_t)3 * MROWS * 256 + (size_t)b * SEQ * 256 + kv * 128;
    const bf16* KW = KVb + (size_t)4 * MROWS * 256 + (size_t)b * SEQ * 256 + kv * 128; const bf16* VW = KVb + (size_t)5 * MROWS * 256 + (size_t)b * SEQ * 256 + kv * 128;
    __syncthreads();
    float sv[16];
    const int ntc = (q0 + 63 >= 31) ? min((q0 + 32) / 512 + 1, 16) : 0;
    float mc = -1e30f, lc = 0.f;
    ATT_TILE_LOOP(ntc, 32 * i_, NCMP - 1, KCb, VCb, false, {
      if (512 * i_ + 31 <= tw_hi) {
        const f32x16 x = qk_tile(buf_, qrow_l, r, h);
        _Pragma("unroll")
        for (int i = 0; i < 16; ++i) { const int n = 32 * i_ + crow(i, h); const bool valid = 16 * n + 31 <= t; sv[i] = valid ? x[i] * LOG2E - slope2 * ((float)(t - 16 * n) - 15.5f) : -1e30f; }
        ATT_PASS1_UPDATE(mc, lc);
      } });
    { const float inv = lc > 0.f ? 1.0f / lc : 0.f;
    ATT_TILE_LOOP(ntc, 32 * i_, NCMP - 1, KCb, VCb, true, {
      if (512 * i_ + 31 <= tw_hi) {
        f32x16 pcs = qk_tile(buf_, qrow_l, r, h);
        _Pragma("unroll")
        for (int i = 0; i < 16; ++i) { const int n = 32 * i_ + crow(i, h); const bool valid = 16 * n + 31 <= t;
          pcs[i] = valid ? __builtin_amdgcn_exp2f(pcs[i] * LOG2E - slope2 * ((float)(t - 16 * n) - 15.5f) - mc) * inv : 0.f; }
        pv_tile(buf_ + KBUF, pcs, g0, o, r, h);
        _Pragma("unroll")
        for (int i = 0; i < 16; ++i) { pcs[i] += __shfl_xor(pcs[i], 1); pcs[i] += __shfl_xor(pcs[i], 2); }
        const float S0 = (pcs[0] + pcs[1]) + (pcs[2] + pcs[3]), S1 = (pcs[4] + pcs[5]) + (pcs[6] + pcs[7]), S2 = (pcs[8] + pcs[9]) + (pcs[10] + pcs[11]), S3 = (pcs[12] + pcs[13]) + (pcs[14] + pcs[15]);
        const float v0 = __shfl_xor(pcs[3], 32), v1 = __shfl_xor(pcs[7], 32), v2 = __shfl_xor(pcs[11], 32), v3 = __shfl_xor(pcs[15], 32);
        if (g == 0) { float* ir = imp + qq * 128 + 8 * i_;
          if (h == 0) { ir[0] += S0; ir[2] += S1 + v0; ir[4] += S2 + v1; ir[6] += S3 + v2; if (8 * i_ + 8 < 128) ir[8] += v3; }
          else { ir[1] += S0 + v0; ir[3] += S1 + v1; ir[5] += S2 + v2; ir[7] += S3 + v3; } }
      } }); }
    unsigned long long wu0 = 0ull, wu1 = 0ull;
    for (int ql = 0; ql < 8; ++ql) {
      const int qi = 8 * w + ql, cur = (q0 + qi) >> 6;
      float v0, v1;
      { const int m = lane, lag = cur - m; v0 = ((m == 0) || (lag >= 0 && lag < 2)) ? 1e9f : (lag >= 0 ? imp[qi * 128 + m] : -1.0f); }
      { const int m = lane + 64, lag = cur - m; v1 = (lag >= 0 && lag < 2) ? 1e9f : (lag >= 0 ? imp[qi * 128 + m] : -1.0f); }
      bool c0 = false, c1 = false;
      for (int rd = 0; rd < 16; ++rd) {
        float best; int bi;
        if (v0 >= v1) { best = v0; bi = lane; } else { best = v1; bi = lane + 64; }
#pragma unroll
        for (int of = 1; of < 64; of <<= 1) { const float ov = __shfl_xor(best, of); const int oi = __shfl_xor(bi, of); if (ov > best || (ov == best && oi < bi)) { best = ov; bi = oi; } }
        if (bi == lane) { c0 = true; v0 = -3e38f; }
        if (bi == lane + 64) { c1 = true; v1 = -3e38f; }
      }
      const unsigned long long b0 = __ballot(c0), b1 = __ballot(c1);
      if (lane == 0) { selm[qi * 4 + 0] = (unsigned)b0; selm[qi * 4 + 1] = (unsigned)(b0 >> 32); selm[qi * 4 + 2] = (unsigned)b1; selm[qi * 4 + 3] = (unsigned)(b1 >> 32); }
      wu0 |= b0; wu1 |= b1;
    }
    if (lane == 0) { wun[w * 4 + 0] = (unsigned)wu0; wun[w * 4 + 1] = (unsigned)(wu0 >> 32); wun[w * 4 + 2] = (unsigned)wu1; wun[w * 4 + 3] = (unsigned)(wu1 >> 32); }
    __syncthreads();
    const unsigned mk0 = selm[qq * 4 + 0], mk1 = selm[qq * 4 + 1], mk2 = selm[qq * 4 + 2], mk3 = selm[qq * 4 + 3];
    if (w == 0) {
      unsigned u0 = 0, u1 = 0, u2 = 0, u3 = 0;
#pragma unroll
      for (int ww = 0; ww < 8; ++ww) { u0 |= wun[ww * 4 + 0]; u1 |= wun[ww * 4 + 1]; u2 |= wun[ww * 4 + 2]; u3 |= wun[ww * 4 + 3]; }
      const unsigned long long U0 = ((unsigned long long)u1 << 32) | u0, U1 = ((unsigned long long)u3 << 32) | u2;
      const bool in0 = ((U0 >> lane) & 1ull) && (lane <= qb), in1 = ((U1 >> lane) & 1ull) && (lane + 64 <= qb);
      const unsigned long long B0 = __ballot(in0), B1 = __ballot(in1);
      const unsigned long long below = (lane == 0) ? 0ull : (~0ull >> (64 - lane));
      if (in0) ulist[__popcll(B0 & below)] = lane;
      if (in1) ulist[__popcll(B0) + __popcll(B1 & below)] = lane + 64;
      if (lane == 0) ulist[160] = __popcll(B0) + __popcll(B1);
    }
    __syncthreads();
    const int nU = ulist[160];
    float ms = -1e30f, ls = 0.f;
    ATT_TILE_LOOP(2 * nU, ulist[i_ >> 1] * 64 + (i_ & 1) * 32, SEQ - 1, KS, VS, false, {
      const int m = ulist[i_ >> 1], pos0 = m * 64 + (i_ & 1) * 32;
      const bool wsel = ((m < 64 ? (wu0 >> m) : (wu1 >> (m - 64))) & 1ull) != 0ull;
      if (wsel && pos0 <= tw_hi) {
        const f32x16 x = qk_tile(buf_, qrow_l, r, h);
        const unsigned wm = m < 32 ? mk0 : m < 64 ? mk1 : m < 96 ? mk2 : mk3; const bool rsel = ((wm >> (m & 31)) & 1u) != 0u;
        _Pragma("unroll")
        for (int i = 0; i < 16; ++i) { const int pos = pos0 + crow(i, h); const bool valid = rsel && pos <= t; sv[i] = valid ? x[i] * LOG2E - slope2 * (float)(t - pos) : -1e30f; }
        ATT_PASS1_UPDATE(ms, ls);
      } });
    { const float inv = ls > 0.f ? g1 / ls : 0.f;
    ATT_TILE_LOOP(2 * nU, ulist[i_ >> 1] * 64 + (i_ & 1) * 32, SEQ - 1, KS, VS, true, {
      const int m = ulist[i_ >> 1], pos0 = m * 64 + (i_ & 1) * 32;
      const bool wsel = ((m < 64 ? (wu0 >> m) : (wu1 >> (m - 64))) & 1ull) != 0ull;
      if (wsel && pos0 <= tw_hi) {
        f32x16 x = qk_tile(buf_, qrow_l, r, h);
        const unsigned wm = m < 32 ? mk0 : m < 64 ? mk1 : m < 96 ? mk2 : mk3; const bool rsel = ((wm >> (m & 31)) & 1u) != 0u;
        _Pragma("unroll")
        for (int i = 0; i < 16; ++i) { const int pos = pos0 + crow(i, h); const bool valid = rsel && pos <= t;
          x[i] = valid ? __builtin_amdgcn_exp2f(x[i] * LOG2E - slope2 * (float)(t - pos) - ms) : 0.f; }
        pv_tile(buf_ + KBUF, x, inv, o, r, h);
      } }); }
    const int wp0 = max(q0 - 512, 0), ntw = (q0 + 64 - wp0) / 32;
    float mw = -1e30f, lw = 0.f;
    ATT_TILE_LOOP(ntw, wp0 + 32 * i_, SEQ - 1, KW, VW, false, {
      const int pos0 = wp0 + 32 * i_;
      if (pos0 <= tw_hi && pos0 + 31 >= tw_lo - 511) {
        const f32x16 x = qk_tile(buf_, qrow_l, r, h);
        _Pragma("unroll")
        for (int i = 0; i < 16; ++i) { const int d = t - (pos0 + crow(i, h)); const bool valid = d >= 0 && d < 512; sv[i] = valid ? x[i] * LOG2E - slope2 * (float)d : -1e30f; }
        ATT_PASS1_UPDATE(mw, lw);
      } });
    { const float inv = lw > 0.f ? g2 / lw : 0.f;
    ATT_TILE_LOOP(ntw, wp0 + 32 * i_, SEQ - 1, KW, VW, true, {
      const int pos0 = wp0 + 32 * i_;
      if (pos0 <= tw_hi && pos0 + 31 >= tw_lo - 511) {
        f32x16 x = qk_tile(buf_, qrow_l, r, h);
        _Pragma("unroll")
        for (int i = 0; i < 16; ++i) { const int d = t - (pos0 + crow(i, h)); const bool valid = d >= 0 && d < 512;
          x[i] = valid ? __builtin_amdgcn_exp2f(x[i] * LOG2E - slope2 * (float)d - mw) : 0.f; }
        pv_tile(buf_ + KBUF, x, inv, o, r, h);
      } }); }
    { char* yb = lds + OFF_Y + R * YROW;
#pragma unroll
      for (int dt = 0; dt < 4; ++dt)
#pragma unroll
        for (int i = 0; i < 16; ++i) *(unsigned short*)(yb + (32 * dt + crow(i, h)) * 2) = (unsigned short)f2bf(o[dt][i]);
      __syncthreads();
      const int RR = tid >> 1, hf = tid & 1; const char* ys = lds + OFF_Y + RR * YROW + hf * 128;
      bf16* yd = YN + ((size_t)b * SEQ + q0 + (RR >> 2)) * 1024 + (kv * 4 + (RR & 3)) * 128 + hf * 64;
#pragma unroll
      for (int c = 0; c < 8; ++c) *(u32x4*)(yd + c * 8) = *(const u32x4*)(ys + c * 16);
      __syncthreads(); }
  }
}
}

namespace sm {
typedef short bf16x8 __attribute__((ext_vector_type(8)));
#define SM_MFMA(a, b, c) __builtin_amdgcn_mfma_f32_16x16x32_bf16((a), (b), (c), 0, 0, 0)
constexpr int PITCH = 272;
__device__ __forceinline__ unsigned pkbf(float lo, float hi) {
  typedef __bf16 v2bf __attribute__((ext_vector_type(2))); typedef float v2f __attribute__((ext_vector_type(2)));
  const v2f f = {lo, hi}; const v2bf b = __builtin_convertvector(f, v2bf); return __builtin_bit_cast(unsigned, b);
}
__device__ __forceinline__ void gmlp_phase(char* lds, bf16* U, const bf16* V, const float* stats, const bf16* WSC, const float* ln_g, const float* ln_b, const float* b_s) {
  const int tid = tid_l(), bid = bid_l(), lane = tid & 63, w = __builtin_amdgcn_readfirstlane(tid >> 6), fr = lane & 15, fq = lane >> 4;
  char* VT = lds; char* YS = lds + 128 * PITCH;
  for (int it = bid; it < (MROWS / 128) * 8; it += gridDim.x) {
    const int n = it >> 3, g = it & 7, r0 = n * 128, c0 = g * 128;
#pragma unroll
    for (int q = 0; q < 4; ++q) { const int ch = tid + q * NT, j = ch >> 4, dc = (ch & 15) * 8;
      const u32x4 raw = *(const u32x4*)(V + (size_t)(r0 + j) * 1024 + c0 + dc);
      const float mu = stats[2 * (r0 + j)], rs = stats[2 * (r0 + j) + 1];
      const f32x4 ga = *(const f32x4*)(ln_g + c0 + dc), gb = *(const f32x4*)(ln_g + c0 + dc + 4), ba = *(const f32x4*)(ln_b + c0 + dc), bb = *(const f32x4*)(ln_b + c0 + dc + 4);
      float e[8] = {bflo(raw.x), bfhi(raw.x), bflo(raw.y), bfhi(raw.y), bflo(raw.z), bfhi(raw.z), bflo(raw.w), bfhi(raw.w)};
      const float gg[8] = {ga[0], ga[1], ga[2], ga[3], gb[0], gb[1], gb[2], gb[3]}, bbv[8] = {ba[0], ba[1], ba[2], ba[3], bb[0], bb[1], bb[2], bb[3]};
#pragma unroll
      for (int k = 0; k < 8; ++k) *(unsigned short*)(VT + (dc + k) * PITCH + j * 2) = (unsigned short)f2bf((e[k] - mu) * rs * gg[k] + bbv[k]); }
    __syncthreads();
    f32x4 acc[8];
#pragma unroll
    for (int nt = 0; nt < 8; ++nt) acc[nt] = (f32x4){0.f, 0.f, 0.f, 0.f};
    const int nks = (16 * w + 15) / 32 + 1;
    const bf16* wrow = WSC + ((size_t)g * 128 + 16 * w + fr) * 128 + 8 * fq;
    for (int ks = 0; ks < nks; ++ks) {
      const bf16x8 a = *(const bf16x8*)(wrow + 32 * ks);
#pragma unroll
      for (int nt = 0; nt < 8; ++nt) { const bf16x8 b = *(const bf16x8*)(VT + (16 * nt + fr) * PITCH + (32 * ks + 8 * fq) * 2); acc[nt] = SM_MFMA(a, b, acc[nt]); }
    }
#pragma unroll
    for (int rg = 0; rg < 4; ++rg) { const int i = 16 * w + 4 * fq + rg; const float bs = b_s[g * 128 + i];
#pragma unroll
      for (int nt = 0; nt < 8; ++nt) *(unsigned short*)(YS + i * PITCH + (16 * nt + fr) * 2) = (unsigned short)f2bf(acc[nt][rg] + bs); }
    __syncthreads();
#pragma unroll
    for (int q = 0; q < 4; ++q) { const int ch = tid + q * NT, i = ch >> 4, dc = (ch & 15) * 8;
      bf16* up = U + (size_t)(r0 + i) * 1024 + c0 + dc;
      const u32x4 uu = *(const u32x4*)up, sg = *(const u32x4*)(YS + i * PITCH + dc * 2);
      u32x4 o; o.x = pkbf(bflo(uu.x) * bflo(sg.x), bfhi(uu.x) * bfhi(sg.x)); o.y = pkbf(bflo(uu.y) * bflo(sg.y), bfhi(uu.y) * bfhi(sg.y));
      o.z = pkbf(bflo(uu.z) * bflo(sg.z), bfhi(uu.z) * bfhi(sg.z)); o.w = pkbf(bflo(uu.w) * bflo(sg.w), bfhi(uu.w) * bfhi(sg.w));
      *(u32x4*)up = o; }
    __syncthreads();
  }
}
__device__ __forceinline__ float gelu_tanh_fast(float x) { const float u = x * (x * x * 0.044715f + 1.0f); return x * __builtin_amdgcn_rcpf(1.0f + __builtin_amdgcn_exp2f(u * (-2.0f * 0.7978845608028654f * 1.4426950408889634f))); }
__device__ __forceinline__ void compress_phase(char* lds, const bf16* KCin, const bf16* VCin, bf16* KC, bf16* VC, const bf16* W1KT, const bf16* W1VT, const bf16* W2KT, const bf16* W2VT, const float* pe_k, const float* pe_v) {
  const int tid = tid_l(), bid = bid_l(), lane = tid & 63, w = __builtin_amdgcn_readfirstlane(tid >> 6), fr = lane & 15, fq = lane >> 4;
  const int srow = tid >> 4, sdc = (tid & 15) * 8;
  char* HS = lds + 2 * 32 * PITCH; char* OS = HS + 32 * PITCH;
  for (int unit = bid; unit < 128; unit += gridDim.x) {
    const int which = unit >> 6, b = (unit >> 5) & 1, h = (unit >> 4) & 1, i0 = (unit & 15) * 32;
    const bf16* src = (which ? VCin : KCin) + (size_t)b * SEQ * 256 + h * 128; const float* pe = which ? pe_v : pe_k;
    const bf16* w1t = (which ? W1VT : W1KT) + (size_t)(16 * w + fr) * 4096 + 8 * fq;
    const int itok = min(i0 + srow, NCMP - 1) * 16;
    f32x4 acc[2] = {(f32x4){0.f, 0.f, 0.f, 0.f}, (f32x4){0.f, 0.f, 0.f, 0.f}};
    u32x4 zr = *(const u32x4*)(src + (size_t)(itok + 0) * 256 + sdc); f32x4 pa = *(const f32x4*)(pe + sdc), pb = *(const f32x4*)(pe + sdc + 4);
    for (int p = 0; p < 32; ++p) {
      char* As = lds + (p & 1) * 32 * PITCH;
      { u32x4 o; o.x = pkbf(bflo(zr.x) + pa[0], bfhi(zr.x) + pa[1]); o.y = pkbf(bflo(zr.y) + pa[2], bfhi(zr.y) + pa[3]); o.z = pkbf(bflo(zr.z) + pb[0], bfhi(zr.z) + pb[1]); o.w = pkbf(bflo(zr.w) + pb[2], bfhi(zr.w) + pb[3]);
        *(u32x4*)(As + srow * PITCH + sdc * 2) = o; }
      if (p + 1 < 32) { zr = *(const u32x4*)(src + (size_t)(itok + p + 1) * 256 + sdc); pa = *(const f32x4*)(pe + (p + 1) * 128 + sdc); pb = *(const f32x4*)(pe + (p + 1) * 128 + sdc + 4); }
      __syncthreads();
#pragma unroll
      for (int ks = 0; ks < 4; ++ks) { const bf16x8 bw = *(const bf16x8*)(w1t + p * 128 + 32 * ks);
        const bf16x8 a0 = *(const bf16x8*)(As + fr * PITCH + (32 * ks + 8 * fq) * 2), a1 = *(const bf16x8*)(As + (16 + fr) * PITCH + (32 * ks + 8 * fq) * 2);
        acc[0] = SM_MFMA(a0, bw, acc[0]); acc[1] = SM_MFMA(a1, bw, acc[1]); }
    }
#pragma unroll
    for (int mt = 0; mt < 2; ++mt)
#pragma unroll
      for (int rg = 0; rg < 4; ++rg) *(unsigned short*)(HS + (16 * mt + 4 * fq + rg) * PITCH + (16 * w + fr) * 2) = (unsigned short)f2bf(gelu_tanh_fast(acc[mt][rg]));
    __syncthreads();
    { const bf16* w2t = (which ? W2VT : W2KT) + (size_t)(16 * w + fr) * 128 + 8 * fq;
      f32x4 o2[2] = {(f32x4){0.f, 0.f, 0.f, 0.f}, (f32x4){0.f, 0.f, 0.f, 0.f}};
#pragma unroll
      for (int ks = 0; ks < 4; ++ks) { const bf16x8 bw = *(const bf16x8*)(w2t + 32 * ks);
        const bf16x8 a0 = *(const bf16x8*)(HS + fr * PITCH + (32 * ks + 8 * fq) * 2), a1 = *(const bf16x8*)(HS + (16 + fr) * PITCH + (32 * ks + 8 * fq) * 2);
        o2[0] = SM_MFMA(a0, bw, o2[0]); o2[1] = SM_MFMA(a1, bw, o2[1]); }
#pragma unroll
      for (int mt = 0; mt < 2; ++mt)
#pragma unroll
        for (int rg = 0; rg < 4; ++rg) *(unsigned short*)(OS + (16 * mt + 4 * fq + rg) * PITCH + (16 * w + fr) * 2) = (unsigned short)f2bf(o2[mt][rg]); }
    __syncthreads();
    if (i0 + srow < NCMP) *(u32x4*)((which ? VC : KC) + ((size_t)(b * NCMP + i0 + srow) * 2 + h) * 128 + sdc) = *(const u32x4*)(OS + srow * PITCH + sdc * 2);
    __syncthreads();
  }
}
}


#ifndef PROBE_LEVEL
#define PROBE_LEVEL 0
#endif
#define PROBE_BUF(L, K, BUF) if (PROBE_LEVEL == (L)) { if (IN(K)) { const int tid = tid_l(), bid = bid_l(); \
      for (size_t e = (size_t)bid * NT + tid; e < (size_t)MROWS * 1024; e += (size_t)gridDim.x * NT) p.out[e] = bf2f((BUF)[e]); } \
    if (p.ph_lo >= (K)) return; }
#define RLX_AGENT __ATOMIC_RELAXED, __HIP_MEMORY_SCOPE_AGENT
#define XB_TMO      128
#define XB_XCNT(j)  (256  + 64 * (j))
#define XB_XSUB(j)  (1280 + 64 * (j))
#define XB_XGEN(j)  (2304 + 64 * (j))
#define XB_TOP      3328
#define XB_TOPGEN   3392
#define XCD_BAR_WORDS 3456
#define XB_SPIN_CAP (1u << 18)

__device__ __forceinline__ unsigned xb_ld(unsigned* p)              { return __hip_atomic_load(p, __ATOMIC_RELAXED, __HIP_MEMORY_SCOPE_AGENT); }
__device__ __forceinline__ unsigned xb_add(unsigned* p, unsigned v) { return __hip_atomic_fetch_add(p, v, __ATOMIC_RELAXED, __HIP_MEMORY_SCOPE_AGENT); }
__device__ __forceinline__ unsigned xb_xcc_id() { return (unsigned)__builtin_amdgcn_s_getreg((3 << 11) | 20) & 0xFu; }
#define XB_SPIN(cond, bar) do { unsigned _sp = 0; while (cond) { __builtin_amdgcn_s_sleep(1); \
    if ((++_sp & 255u) == 0u) { if (xb_ld(&(bar)[XB_TMO])) break; if (_sp > XB_SPIN_CAP) { atomicAdd(&(bar)[XB_TMO], 1u); break; } } } } while (0)

struct XcdBarrier {
    unsigned* bar; unsigned x;
    volatile LAS unsigned* st;
};

__device__ __forceinline__ XcdBarrier xcd_barrier_post(unsigned* bar, volatile LAS unsigned* st) {
    XcdBarrier b; b.bar = bar; b.x = xb_xcc_id(); b.st = st;
    if (threadIdx.x == 0) (void)xb_add(&bar[XB_XCNT(b.x)], 1u);
    return b;
}
__device__ __forceinline__ void xcd_barrier_complete(unsigned* bar, unsigned x, unsigned& nloc, unsigned& nx) {
    const unsigned G = gridDim.x * gridDim.y * gridDim.z;
    unsigned sum, cnt, mine, sp = 0u;
    for (;;) {
        sum = 0u; cnt = 0u; mine = 0u;
#pragma unroll
        for (unsigned j = 0; j < 16; ++j) { const unsigned c = xb_ld(&bar[XB_XCNT(j)]); sum += c; cnt += (c > 0u) ? 1u : 0u; mine = (j == x) ? c : mine; }
        if (sum == G) break;
        __builtin_amdgcn_s_sleep(1);
        if ((++sp & 255u) == 0u) { if (xb_ld(&bar[XB_TMO])) break; if (sp > XB_SPIN_CAP) { atomicAdd(&bar[XB_TMO], 1u); break; } }
    }
    nloc = mine > 0u ? mine : 1u; nx = cnt > 0u ? cnt : 1u;
}

__device__ __forceinline__ void xcd_barrier(const XcdBarrier& b) {
    asm volatile("s_waitcnt vmcnt(0)" ::: "memory");
    __syncthreads();
    if (threadIdx.x == 0) {
        unsigned* bar = b.bar;
        __builtin_amdgcn_s_waitcnt(0);
        unsigned nloc = b.st[0], nx = b.st[1];
        if (nloc == 0u) { xcd_barrier_complete(bar, b.x, nloc, nx); b.st[0] = nloc; b.st[1] = nx; }
        const unsigned old = xb_add(&bar[XB_XSUB(b.x)], 1u);
        const unsigned gen = old / nloc;
        if (old + 1u == (gen + 1u) * nloc) {
            __builtin_amdgcn_fence(__ATOMIC_RELEASE, "agent");
            asm volatile("s_waitcnt vmcnt(0)" ::: "memory");
            const unsigned og = xb_add(&bar[XB_TOP], 1u);
            const unsigned tg = og / nx;
            if (og + 1u == (tg + 1u) * nx) xb_add(&bar[XB_TOPGEN], 1u);
            else XB_SPIN(xb_ld(&bar[XB_TOPGEN]) == tg, bar);
            __builtin_amdgcn_fence(__ATOMIC_ACQUIRE, "agent");
            xb_add(&bar[XB_XGEN(b.x)], 1u);
            asm volatile("s_waitcnt vmcnt(0)" ::: "memory");
        } else {
            XB_SPIN(xb_ld(&bar[XB_XGEN(b.x)]) == gen, bar);
            __builtin_amdgcn_fence(__ATOMIC_ACQUIRE, "agent");
            asm volatile("s_waitcnt vmcnt(0)" ::: "memory");
        }
    }
    __syncthreads();
}


__global__ void __launch_bounds__(NT, 2) fwd_megakernel(Params p) {
  extern __shared__ __attribute__((aligned(16))) unsigned char lds_raw[];
  float* ldsf = (float*)lds_raw;
  PG8_LAS unsigned char* ldsl = (PG8_LAS unsigned char*)lds_raw;
  cg::grid_group grid = cg::this_grid();
  volatile LAS unsigned* MISC = (volatile LAS unsigned*)((LAS unsigned char*)lds_raw + 147456 - 64);
  if (threadIdx.x < 16) MISC[threadIdx.x] = 0u;
  __syncthreads();
  const bool multi = (p.ph_hi - p.ph_lo) > 1;
  XcdBarrier bar; bar.bar = (unsigned*)p.ws; bar.x = 0; bar.st = MISC;
  if (multi) { grid.sync(); bar = xcd_barrier_post((unsigned*)p.ws, MISC); }
#define IN(k) (p.ph_lo <= (k) && (k) < p.ph_hi)
#define SEAM(k) do { if (IN(k) && IN((k) + 1)) xcd_barrier(bar); } while (0)
  unsigned char* ws = p.ws;
  bf16* W_IN = (bf16*)(ws + WS_WIN); bf16* W_PGM = (bf16*)(ws + WS_WPGM); bf16* W_PNSA = (bf16*)(ws + WS_WPNSA); bf16* W_OUT = (bf16*)(ws + WS_WOUT);
  bf16* W_FF1 = (bf16*)(ws + WS_WFF1); bf16* W_FF2 = (bf16*)(ws + WS_WFF2);
  bf16* KC = (bf16*)(ws + WS_KC); bf16* VC = (bf16*)(ws + WS_VC); float* stats = (float*)(ws + WS_STATS);
  bf16* XB = (bf16*)(ws + WS_XB); bf16* U = (bf16*)(ws + WS_U); bf16* V = (bf16*)(ws + WS_V); bf16* Q = (bf16*)(ws + WS_Q); bf16* KVb = (bf16*)(ws + WS_KV);
  bf16* TB = (bf16*)(ws + WS_T); bf16* SB = (bf16*)(ws + WS_S); bf16* MERGED = (bf16*)(ws + WS_MERGED); bf16* HB = (bf16*)(ws + WS_HB); bf16* A = (bf16*)(ws + WS_A);
  bf16* YN = (bf16*)(ws + WS_YN);
  const int bx = blockIdx.x;
  if (IN(0)) p0_prologue(p, lds_raw);
  SEAM(0);
  if (IN(1)) { pg8::Gemm g{XB, W_IN, MROWS, NINP, D}; pg8::StaticOrder S; S.init(MROWS, NINP, gridDim.x, bx);
    pg8::EpiIn E{U, V, Q, KVb};
    pg8::gemm_phase<pg8::EpiIn, pg8::StaticOrder, true, true>(ldsl, g, S, E); }
  SEAM(1);
  if (IN(2)) { vstats_phase(V, stats); sm::compress_phase((char*)lds_raw, KVb, KVb + (size_t)MROWS * 256, KC, VC, (const bf16*)(ws + WS_W1K), (const bf16*)(ws + WS_W1V), (const bf16*)(ws + WS_W2K), (const bf16*)(ws + WS_W2V), p.pe_k, p.pe_v); }
  SEAM(2);
  if (IN(3)) { sm::gmlp_phase((char*)lds_raw, U, V, stats, (const bf16*)(ws + WS_WSC), p.gm_ln_g, p.gm_ln_b, p.gm_b_s); att::attn_phase((char*)lds_raw, Q, YN, KVb, p.x, (const float*)(ws + WS_WG), KC, VC); }
  SEAM(3);
  if (IN(4)) {
    { pg8::Gemm g{XB, W_IN + (size_t)4608 * 1024, MROWS, D, D}; pg8::StaticOrder S; S.init(MROWS, D, gridDim.x, bx);
      pg8::EpiMix<3> E{TB, 1024, nullptr, nullptr};
      pg8::gemm_phase<pg8::EpiMix<3>, pg8::StaticOrder, false, true>(ldsl, g, S, E); }
    asm volatile("s_waitcnt vmcnt(0)" ::: "memory"); __syncthreads();
    { pg8::Gemm g{U, W_PGM, MROWS, D, D}; pg8::StaticOrder S; S.init(MROWS, D, gridDim.x, bx);
      pg8::EpiMix<4> E{TB, 1024, TB, nullptr};
      pg8::gemm_phase<pg8::EpiMix<4>, pg8::StaticOrder, false, true>(ldsl, g, S, E); }
    asm volatile("s_waitcnt vmcnt(0)" ::: "memory"); __syncthreads();
    { pg8::Gemm g{XB, W_IN + (size_t)5632 * 1024, MROWS, D, D}; pg8::StaticOrder S; S.init(MROWS, D, gridDim.x, bx);
      pg8::EpiMix<3> E{SB, 1024, nullptr, nullptr};
      pg8::gemm_phase<pg8::EpiMix<3>, pg8::StaticOrder, false, true>(ldsl, g, S, E); }
    asm volatile("s_waitcnt vmcnt(0)" ::: "memory"); __syncthreads();
    { pg8::Gemm g{YN, W_PNSA, MROWS, D, D}; pg8::StaticOrder S; S.init(MROWS, D, gridDim.x, bx);
      pg8::EpiMix<5> E{MERGED, 1024, TB, SB};
      pg8::gemm_phase<pg8::EpiMix<5>, pg8::StaticOrder, false, true>(ldsl, g, S, E); }
  }
  SEAM(4);
  SEAM(5);
  if (IN(6)) { pg8::Gemm g{MERGED, W_OUT, MROWS, D, D}; pg8::StaticOrder S; S.init(MROWS, D, gridDim.x, bx);
    pg8::EpiRes E{p.out, p.x};
    pg8::gemm_phase<pg8::EpiRes, pg8::StaticOrder, true, true>(ldsl, g, S, E); }
  SEAM(6);
  if (IN(7)) ln_rows_phase(p.out, p.ln1_g, p.ln1_b, HB);
  SEAM(7);
  if (IN(8)) { pg8::Gemm g{HB, W_FF1, MROWS, DFF, D}; pg8::StaticOrder S; S.init(MROWS, DFF, gridDim.x, bx);
    pg8::EpiMix<0> E{A, DFF, nullptr, nullptr};
    pg8::gemm_phase<pg8::EpiMix<0>, pg8::StaticOrder, true, true>(ldsl, g, S, E); }
  SEAM(8);
  if (IN(9)) { pg8::Gemm g{A, W_FF2, MROWS, D, DFF}; pg8::StaticOrder S; S.init(MROWS, D, gridDim.x, bx);
    pg8::EpiRes E{p.out, p.out};
    pg8::gemm_phase<pg8::EpiRes, pg8::StaticOrder, true, true>(ldsl, g, S, E); }
  SEAM(9);
  if (IN(10)) ln_rows_phase(p.out, p.ln2_g, p.ln2_b, nullptr);
}

extern "C" void kernel_launch(void* const* d_in, const int* in_sizes, int n_in,
                              void* d_out, int out_size, void* d_ws, size_t ws_size,
                              hipStream_t stream) {
  static int grid_blocks = 0;
  if (!grid_blocks) {
    int dev = 0, cus = 0, per_cu = 0;
    (void)hipGetDevice(&dev);
    (void)hipDeviceGetAttribute(&cus, hipDeviceAttributeMultiprocessorCount, dev);
    (void)hipFuncSetAttribute((const void*)fwd_megakernel, hipFuncAttributeMaxDynamicSharedMemorySize, LDS_BYTES);
    (void)hipOccupancyMaxActiveBlocksPerMultiprocessor(&per_cu, (const void*)fwd_megakernel, NT, LDS_BYTES);
    if (per_cu < 1) fprintf(stderr, "kernel_launch: occupancy query says %d blocks/CU\n", per_cu);
    grid_blocks = cus;
  }
  Params p{};
  const float* const* in = (const float* const*)d_in;
  p.x = in[0]; p.w_in = in[1]; p.gm_ln_g = in[2]; p.gm_ln_b = in[3]; p.gm_w_s = in[4]; p.gm_b_s = in[5];
  p.pe_k = in[6]; p.w1_k = in[7]; p.w2_k = in[8]; p.pe_v = in[9]; p.w1_v = in[10]; p.w2_v = in[11];
  p.w_pgm = in[12]; p.w_pnsa = in[13]; p.w_out = in[14]; p.ln1_g = in[15]; p.ln1_b = in[16];
  p.w_ff1 = in[17]; p.w_ff2 = in[18]; p.ln2_g = in[19]; p.ln2_b = in[20];
  p.out = (float*)d_out; p.ws = (unsigned char*)d_ws;
  (void)hipMemsetAsync(d_ws, 0, 65536, stream);
#ifndef N_LAUNCH_SPLIT
#define N_LAUNCH_SPLIT 0
#endif
  if (N_LAUNCH_SPLIT) {
    for (int k = 0; k < 11; ++k) { p.ph_lo = k; p.ph_hi = k + 1; hipLaunchKernelGGL(fwd_megakernel, dim3(grid_blocks), dim3(NT), LDS_BYTES, stream, p); }
    return;
  }
  p.ph_lo = 0; p.ph_hi = 11;
  void* args[] = {&p};
  hipError_t e = hipLaunchCooperativeKernel((const void*)fwd_megakernel, dim3(grid_blocks), dim3(NT), args, LDS_BYTES, stream);
  if (e != hipSuccess) fprintf(stderr, "cooperative launch failed: %s (grid %d)\n", hipGetErrorString(e), grid_blocks);
}
```
